# Optimizing an MI355X kernel written in HIP

```python
import math
import jax
import jax.numpy as jnp
from jax import lax
import numpy as np

D_MODEL = 1024
BATCH = 8
SEQ = 8192
DEPTH = 2

HEAD_DIM = 64
ATTN_SCALE = HEAD_DIM ** -0.5
SWA_HEADS = D_MODEL // 128
SWA_KV_HEADS = SWA_HEADS // 4
SWA_GROUP = SWA_HEADS // SWA_KV_HEADS
SWA_WINDOW = 128
SWA_BLOCK = 128
SC_WIDTH = D_MODEL // 2
SC_KSIZE = 3
MOBA_HEADS = D_MODEL // 128
MOBA_BLOCK = 256
MOBA_TOPK = 3
MOBA_QCHUNK = 32
N_ALIBI_HEADS = SWA_HEADS + MOBA_HEADS
FFN_HIDDEN = -(-8 * D_MODEL // (3 * 256)) * 256
ALPHA = (2 * DEPTH) ** 0.25
BETA = (8 * DEPTH) ** -0.25
LN_EPS = 1e-5

A_Q = SWA_HEADS * HEAD_DIM
A_KV = SWA_KV_HEADS * HEAD_DIM
C_QKV = MOBA_HEADS * HEAD_DIM
PROJ_SIZES = (A_Q, A_KV, A_KV,
              SC_WIDTH, SC_WIDTH, SC_WIDTH,
              C_QKV, C_QKV, C_QKV,
              D_MODEL, D_MODEL, D_MODEL)
PROJ_SPLITS = tuple(int(s) for s in np.cumsum(PROJ_SIZES)[:-1])
PROJ_WIDTH = int(sum(PROJ_SIZES))

kernel_name = 'hybrid_swa_shortconv_moba_deepnorm'


def alibi_slopes():
    i = jnp.arange(N_ALIBI_HEADS, dtype=jnp.float32)
    s = jnp.exp2(-8.0 * (i + 1.0) / N_ALIBI_HEADS)
    return s[:SWA_HEADS], s[SWA_HEADS:]


def layer_norm(x, g, b):
    xf = x.astype(jnp.float32)
    mu = jnp.mean(xf, axis=-1, keepdims=True)
    var = jnp.mean(jnp.square(xf - mu), axis=-1, keepdims=True)
    y = (xf - mu) * lax.rsqrt(var + LN_EPS) * g.astype(jnp.float32) + b.astype(jnp.float32)
    return y.astype(x.dtype)


def sliding_window_attention(q, k, v, sinks, slopes):
    B, S = q.shape[0], q.shape[1]
    nb = S // SWA_BLOCK
    qb = q.reshape(B, nb, SWA_BLOCK, SWA_KV_HEADS, SWA_GROUP, HEAD_DIM).astype(jnp.float32)
    kb = k.reshape(B, nb, SWA_BLOCK, SWA_KV_HEADS, HEAD_DIM)
    vb = v.reshape(B, nb, SWA_BLOCK, SWA_KV_HEADS, HEAD_DIM)
    shift = ((0, 0), (1, 0), (0, 0), (0, 0), (0, 0))
    kw = jnp.concatenate([jnp.pad(kb, shift)[:, :-1], kb], axis=2)
    vw = jnp.concatenate([jnp.pad(vb, shift)[:, :-1], vb], axis=2)
    logits = jnp.einsum('bnqhgd,bnkhd->bnhgqk', qb, kw.astype(jnp.float32)) * ATTN_SCALE
    blk = jnp.arange(nb)[:, None] * SWA_BLOCK
    qpos = blk + jnp.arange(SWA_BLOCK)[None, :]
    kpos = blk - SWA_BLOCK + jnp.arange(2 * SWA_BLOCK)[None, :]
    dist = qpos[:, :, None] - kpos[:, None, :]
    allowed = (dist >= 0) & (dist < SWA_WINDOW) & (kpos[:, None, :] >= 0)
    sl = slopes.reshape(SWA_KV_HEADS, SWA_GROUP)[:, :, None, None]
    logits = logits - sl * dist[:, None, None].astype(jnp.float32)
    logits = jnp.where(allowed[:, None, None], logits, -jnp.inf)
    sink = sinks.astype(jnp.float32).reshape(SWA_KV_HEADS, SWA_GROUP)[:, :, None, None]
    m = jnp.maximum(jnp.max(logits, axis=-1, keepdims=True), sink)
    p = jnp.exp(logits - m)
    denom = jnp.sum(p, axis=-1, keepdims=True) + jnp.exp(sink - m)
    out = jnp.einsum('bnhgqk,bnkhd->bnqhgd', p / denom, vw.astype(jnp.float32))
    return out.reshape(B, S, SWA_HEADS * HEAD_DIM).astype(q.dtype)


def gated_short_conv(h, gate_b, gate_c, conv_w):
    u = gate_c * h
    up = jnp.pad(u, ((0, 0), (SC_KSIZE - 1, 0), (0, 0)))
    S = h.shape[1]
    conv = up[:, 0:S] * conv_w[0] + up[:, 1:S + 1] * conv_w[1] + up[:, 2:S + 2] * conv_w[2]
    return gate_b * conv


def moba_attention(q, k, v, slopes):
    B, S = q.shape[0], q.shape[1]
    sp = -(-S // MOBA_BLOCK) * MOBA_BLOCK
    pad = ((0, 0), (0, sp - S), (0, 0), (0, 0))
    q, k, v = [jnp.pad(t, pad).transpose(0, 2, 1, 3) for t in (q, k, v)]
    nblk = sp // MOBA_BLOCK
    top = min(MOBA_TOPK, nblk)
    kbl = k.reshape(B, MOBA_HEADS, nblk, MOBA_BLOCK, HEAD_DIM)
    vbl = v.reshape(B, MOBA_HEADS, nblk, MOBA_BLOCK, HEAD_DIM)
    kmean = jnp.mean(kbl.astype(jnp.float32), axis=3)
    gate = jnp.einsum('bhsd,bhnd->bhsn', q.astype(jnp.float32), kmean)
    cur = jnp.arange(sp) // MOBA_BLOCK
    past = jnp.arange(nblk)[None, :] < cur[:, None]
    gate = jnp.where(past, gate, -jnp.inf)
    _, idx = lax.top_k(gate, top)
    nch = sp // MOBA_QCHUNK
    q_ch = q.reshape(B, MOBA_HEADS, nch, MOBA_QCHUNK, HEAD_DIM).transpose(2, 0, 1, 3, 4)
    idx_ch = idx.reshape(B, MOBA_HEADS, nch, MOBA_QCHUNK, top).transpose(2, 0, 1, 3, 4)
    bi = jnp.arange(B)[:, None, None, None]
    hi = jnp.arange(MOBA_HEADS)[None, :, None, None]
    sl4 = slopes[None, :, None, None]
    sl5 = slopes[None, :, None, None, None]
    koff = jnp.arange(MOBA_BLOCK)

    def chunk(args):
        c, qc, ic = args
        qpos = c * MOBA_QCHUNK + jnp.arange(MOBA_QCHUNK)
        own = (c * MOBA_QCHUNK) // MOBA_BLOCK
        qf = qc.astype(jnp.float32)
        kg = kbl[bi, hi, ic].astype(jnp.float32)
        vg = vbl[bi, hi, ic].astype(jnp.float32)
        ls = jnp.einsum('bhqd,bhqjkd->bhqjk', qf, kg) * ATTN_SCALE
        kpos_sel = ic[..., None] * MOBA_BLOCK + koff
        dist_sel = (qpos[None, None, :, None, None] - kpos_sel).astype(jnp.float32)
        valid = jnp.arange(top)[None, :] < (qpos // MOBA_BLOCK)[:, None]
        ls = jnp.where(valid[None, None, :, :, None], ls - sl5 * dist_sel, -jnp.inf)
        kown = lax.dynamic_index_in_dim(kbl, own, axis=2, keepdims=False).astype(jnp.float32)
        vown = lax.dynamic_index_in_dim(vbl, own, axis=2, keepdims=False).astype(jnp.float32)
        lo = jnp.einsum('bhqd,bhkd->bhqk', qf, kown) * ATTN_SCALE
        dist_own = qpos[:, None] - (own * MOBA_BLOCK + koff)[None, :]
        lo = jnp.where(dist_own >= 0, lo - sl4 * dist_own.astype(jnp.float32), -jnp.inf)
        logits = jnp.concatenate([ls.reshape(B, MOBA_HEADS, MOBA_QCHUNK, top * MOBA_BLOCK), lo], axis=-1)
        p = jax.nn.softmax(logits, axis=-1)
        ps = p[..., :top * MOBA_BLOCK].reshape(B, MOBA_HEADS, MOBA_QCHUNK, top, MOBA_BLOCK)
        po = p[..., top * MOBA_BLOCK:]
        return (jnp.einsum('bhqjk,bhqjkd->bhqd', ps, vg)
                + jnp.einsum('bhqk,bhkd->bhqd', po, vown))

    out = lax.map(chunk, (jnp.arange(nch), q_ch, idx_ch))
    out = out.transpose(1, 0, 3, 2, 4).reshape(B, sp, MOBA_HEADS * HEAD_DIM)[:, :S]
    return out.astype(q.dtype)


def hybrid_mixer(x, w_in, sinks, conv_w, w_br_a, w_br_b, w_br_c, w_out):
    B, S = x.shape[0], x.shape[1]
    proj = jnp.einsum('bsd,de->bse', x, w_in)
    a_q, a_k, a_v, b_h, b_b, b_c, c_q, c_k, c_v, g_a, g_b, g_c = jnp.split(proj, PROJ_SPLITS, axis=-1)
    slopes_a, slopes_c = alibi_slopes()
    y_a = sliding_window_attention(
        a_q.reshape(B, S, SWA_HEADS, HEAD_DIM),
        a_k.reshape(B, S, SWA_KV_HEADS, HEAD_DIM),
        a_v.reshape(B, S, SWA_KV_HEADS, HEAD_DIM), sinks, slopes_a)
    y_b = gated_short_conv(b_h, b_b, b_c, conv_w)
    y_c = moba_attention(
        c_q.reshape(B, S, MOBA_HEADS, HEAD_DIM),
        c_k.reshape(B, S, MOBA_HEADS, HEAD_DIM),
        c_v.reshape(B, S, MOBA_HEADS, HEAD_DIM), slopes_c)
    merged = (jax.nn.sigmoid(g_a) * (y_a @ w_br_a)
              + jax.nn.sigmoid(g_b) * (y_b @ w_br_b)
              + jax.nn.sigmoid(g_c) * (y_c @ w_br_c))
    return merged @ w_out


def swiglu(x, w_gate, w_up, w_down):
    return (jax.nn.silu(x @ w_gate) * (x @ w_up)) @ w_down


def setup_inputs(seed: int = 0) -> dict:
    key = jax.random.key(seed)
    ks = jax.random.split(key, 16)
    f32 = jnp.float32
    nrm = lambda k, shape, s: jax.random.normal(k, shape, f32) * s
    L = DEPTH
    br_in = SWA_HEADS * HEAD_DIM
    return {
        'x': jax.random.normal(ks[0], (BATCH, SEQ, D_MODEL), f32),
        'w_in': nrm(ks[1], (L, D_MODEL, PROJ_WIDTH), D_MODEL ** -0.5),
        'attn_sinks': nrm(ks[2], (L, SWA_HEADS), 0.5),
        'conv_w': nrm(ks[3], (L, SC_KSIZE, SC_WIDTH), SC_KSIZE ** -0.5),
        'w_branch_a': nrm(ks[4], (L, br_in, D_MODEL), br_in ** -0.5 * BETA),
        'w_branch_b': nrm(ks[5], (L, SC_WIDTH, D_MODEL), SC_WIDTH ** -0.5 * BETA),
        'w_branch_c': nrm(ks[6], (L, MOBA_HEADS * HEAD_DIM, D_MODEL), (MOBA_HEADS * HEAD_DIM) ** -0.5 * BETA),
        'w_out': nrm(ks[7], (L, D_MODEL, D_MODEL), D_MODEL ** -0.5 * BETA),
        'ln1_g': 1.0 + nrm(ks[8], (L, D_MODEL), 0.02),
        'ln1_b': nrm(ks[9], (L, D_MODEL), 0.02),
        'w_ffn_gate': nrm(ks[10], (L, D_MODEL, FFN_HIDDEN), D_MODEL ** -0.5 * BETA),
        'w_ffn_up': nrm(ks[11], (L, D_MODEL, FFN_HIDDEN), D_MODEL ** -0.5 * BETA),
        'w_ffn_down': nrm(ks[12], (L, FFN_HIDDEN, D_MODEL), FFN_HIDDEN ** -0.5 * BETA),
        'ln2_g': 1.0 + nrm(ks[13], (L, D_MODEL), 0.02),
        'ln2_b': nrm(ks[14], (L, D_MODEL), 0.02),
    }


def reference(x, w_in, attn_sinks, conv_w, w_branch_a, w_branch_b, w_branch_c, w_out,
              ln1_g, ln1_b, w_ffn_gate, w_ffn_up, w_ffn_down, ln2_g, ln2_b):
    for l in range(DEPTH):
        mix = hybrid_mixer(x, w_in[l], attn_sinks[l], conv_w[l], w_branch_a[l],
                           w_branch_b[l], w_branch_c[l], w_out[l])
        x = layer_norm(ALPHA * x + mix, ln1_g[l], ln1_b[l])
        ffn = swiglu(x, w_ffn_gate[l], w_ffn_up[l], w_ffn_down[l])
        x = layer_norm(ALPHA * x + ffn, ln2_g[l], ln2_b[l])
    return x
```

```cpp
#include <hip/hip_runtime.h>
#include <hip/hip_cooperative_groups.h>
#include <cstdio>
#include <cstdint>
#include <cmath>
namespace cg = cooperative_groups;

#ifndef N_LAUNCH
#define N_LAUNCH 1
#endif

namespace pg8 {
#define PG8_LAS __attribute__((address_space(3)))
typedef unsigned short bf16_t;
typedef short bf16x8 __attribute__((ext_vector_type(8)));
typedef float f32x4 __attribute__((ext_vector_type(4)));
typedef unsigned u32x4 __attribute__((ext_vector_type(4)));
constexpr int BM = 256, BK = 64, HALF = 128, HTB = HALF * BK * 2  , STAGE_BYTES = 8 * HTB;

__host__ __device__ __forceinline__ int lds_byte(int r, int c) { const int st = (r >> 4) * 2 + (c >> 5), rr = r & 15, cc = c & 31, ob = rr * 64 + cc * 2; return st * 1024 + (ob ^ (((ob >> 9) & 1) << 5)); }
__host__ __device__ __forceinline__ void stage_rc(int b, int& R, int& C) { const int st = b / 1024, sb = b % 1024, swz = sb ^ (((sb >> 9) & 1) << 5); R = (st >> 1) * 16 + swz / 64; C = (st & 1) * 32 + (swz % 64) / 2; }
__host__ __device__ __forceinline__ int perm32(int rho) { const int n = rho >> 4, i = rho & 15; return 8 * (i >> 2) + 4 * n + (i & 3); }

struct Unit { int pm, pn; };
struct Gemm { const bf16_t* A; const bf16_t* Bt; int K; int lda; size_t apstride; };

struct PanelSched {
    int pm, nN;
    __device__ __forceinline__ bool next(int i, Unit& u) const { if (i >= nN) return false; u.pm = pm; u.pn = i; return true; }
    __device__ __forceinline__ void a_ready(const Unit&) const {}
    __device__ __forceinline__ void done(const Unit&) const {}
};

typedef float f32x2 __attribute__((ext_vector_type(2)));
typedef __bf16 bf16x2_t __attribute__((ext_vector_type(2)));
__device__ __forceinline__ unsigned cvt_pk_bf16(float lo, float hi) { f32x2 v = {lo, hi}; bf16x2_t b = __builtin_convertvector(v, bf16x2_t); return __builtin_bit_cast(unsigned, b); }
__device__ __forceinline__ float bf_lo(unsigned u) { return __uint_as_float(u << 16); }
__device__ __forceinline__ float bf_hi(unsigned u) { return __uint_as_float(u & 0xffff0000u); }
__device__ __forceinline__ float sigmoidf_(float x) { return __builtin_amdgcn_rcpf(1.0f + __builtin_amdgcn_exp2f(-1.4426950408889634f * x)); }

template <int ACT  > struct EpiStore {
    static constexpr bool PERM = true, AFTER_DRAIN = false;
    bf16_t* O; int ldc; size_t pstride;
    __device__ __forceinline__ void operator()(const f32x4 (&acc)[2][2][4][2], const Unit& u, int wr, int wc, int fr, int fq) const {
        bf16_t* base = O + (size_t)u.pm * pstride + (size_t)(wr * 64 + fr) * ldc + u.pn * BM + wc * 32 + 8 * fq;
#pragma unroll
        for (int ai = 0; ai < 2; ++ai)
#pragma unroll
            for (int m = 0; m < 4; ++m) { bf16_t* rowp = base + (size_t)(ai * HALF + m * 16) * ldc;
#pragma unroll
                for (int bj = 0; bj < 2; ++bj) { f32x4 v0 = acc[ai][bj][m][0], v1 = acc[ai][bj][m][1];
                    if (ACT == 1) { v0 = (f32x4){sigmoidf_(v0[0]), sigmoidf_(v0[1]), sigmoidf_(v0[2]), sigmoidf_(v0[3])}; v1 = (f32x4){sigmoidf_(v1[0]), sigmoidf_(v1[1]), sigmoidf_(v1[2]), sigmoidf_(v1[3])}; }
                    u32x4 w; w.x = cvt_pk_bf16(v0[0], v0[1]); w.y = cvt_pk_bf16(v0[2], v0[3]); w.z = cvt_pk_bf16(v1[0], v1[1]); w.w = cvt_pk_bf16(v1[2], v1[3]);
                    *(u32x4*)(rowp + bj * HALF) = w; } }
    }
};
struct EpiStoreS1 {
    static constexpr bool PERM = true, AFTER_DRAIN = false;
    bf16_t* O; int ldc; size_t pstride; bf16_t* KF; PG8_LAS float* ksum;
    __device__ __forceinline__ void operator()(const f32x4 (&acc)[2][2][4][2], const Unit& u, int wr, int wc, int fr, int fq) const {
        bf16_t* base = O + (size_t)u.pm * pstride + (size_t)(wr * 64 + fr) * ldc + u.pn * BM + wc * 32 + 8 * fq;
        const bool kt = (u.pn == 11 || u.pn == 12);
        const size_t kbase = ((size_t)((u.pm >> 5) * 8 + (u.pn - 11) * 4 + (wc >> 1)) * 128 + (size_t)(u.pm & 31) * 4 + wr) * 4096
                           + (size_t)((2 * (wc & 1) + (fq >> 1)) * 64 + fr + 32 * (fq & 1)) * 8;
#pragma unroll
        for (int ai = 0; ai < 2; ++ai)
#pragma unroll
            for (int m = 0; m < 4; ++m) { bf16_t* rowp = base + (size_t)(ai * HALF + m * 16) * ldc;
#pragma unroll
                for (int bj = 0; bj < 2; ++bj) { const f32x4 v0 = acc[ai][bj][m][0], v1 = acc[ai][bj][m][1];
                    u32x4 w; w.x = cvt_pk_bf16(v0[0], v0[1]); w.y = cvt_pk_bf16(v0[2], v0[3]); w.z = cvt_pk_bf16(v1[0], v1[1]); w.w = cvt_pk_bf16(v1[2], v1[3]);
                    if (!kt) *(u32x4*)(rowp + bj * HALF) = w;
                    else *(u32x4*)(KF + kbase + (size_t)(2 * bj) * 128 * 4096 + (size_t)(2 * ai) * 4096 + (size_t)((m >> 1) * 4 * 64 + 16 * (m & 1)) * 8) = w; } }
        if (kt) {
#pragma unroll
            for (int bj = 0; bj < 2; ++bj) {
                float cs[8];
#pragma unroll
                for (int j = 0; j < 8; ++j) cs[j] = 0.f;
#pragma unroll
                for (int ai = 0; ai < 2; ++ai)
#pragma unroll
                    for (int m = 0; m < 4; ++m)
#pragma unroll
                        for (int j = 0; j < 8; ++j) cs[j] += acc[ai][bj][m][j >> 2][j & 3];
#pragma unroll
                for (int j = 0; j < 8; ++j) { float v = cs[j]; v += __shfl_xor(v, 1); v += __shfl_xor(v, 2); v += __shfl_xor(v, 4); v += __shfl_xor(v, 8); cs[j] = v; }
                if (fr == 0) {
                    PG8_LAS float* kp = ksum + (u.pn - 11) * 256 + bj * HALF + wc * 32 + 8 * fq;
#pragma unroll
                    for (int j = 0; j < 8; ++j) __hip_atomic_fetch_add(kp + j, cs[j], __ATOMIC_RELAXED, __HIP_MEMORY_SCOPE_WORKGROUP);
                }
            }
        }
    }
};
struct EpiBranch {
    static constexpr bool PERM = true, AFTER_DRAIN = false;
    const bf16_t* G; bf16_t* Mg; size_t pstride; int first;
    __device__ __forceinline__ void operator()(const f32x4 (&acc)[2][2][4][2], const Unit& u, int wr, int wc, int fr, int fq) const {
        const size_t off0 = (size_t)u.pm * pstride + (size_t)(wr * 64 + fr) * 1024 + u.pn * BM + wc * 32 + 8 * fq;
#pragma unroll
        for (int ai = 0; ai < 2; ++ai) {
            u32x4 g[4][2], o[4][2];
#pragma unroll
            for (int m = 0; m < 4; ++m)
#pragma unroll
                for (int bj = 0; bj < 2; ++bj) { const size_t off = off0 + (size_t)(ai * HALF + m * 16) * 1024 + bj * HALF;
                    g[m][bj] = *(const u32x4*)(G + off); o[m][bj] = (u32x4){0u, 0u, 0u, 0u}; if (!first) o[m][bj] = *(const u32x4*)(Mg + off); }
#pragma unroll
            for (int m = 0; m < 4; ++m)
#pragma unroll
                for (int bj = 0; bj < 2; ++bj) { const size_t off = off0 + (size_t)(ai * HALF + m * 16) * 1024 + bj * HALF;
                    const f32x4 v0 = acc[ai][bj][m][0], v1 = acc[ai][bj][m][1]; const u32x4 gg = g[m][bj], oo = o[m][bj]; u32x4 w;
                    w.x = cvt_pk_bf16(bf_lo(oo.x) + bf_lo(gg.x) * v0[0], bf_hi(oo.x) + bf_hi(gg.x) * v0[1]);
                    w.y = cvt_pk_bf16(bf_lo(oo.y) + bf_lo(gg.y) * v0[2], bf_hi(oo.y) + bf_hi(gg.y) * v0[3]);
                    w.z = cvt_pk_bf16(bf_lo(oo.z) + bf_lo(gg.z) * v1[0], bf_hi(oo.z) + bf_hi(gg.z) * v1[1]);
                    w.w = cvt_pk_bf16(bf_lo(oo.w) + bf_lo(gg.w) * v1[2], bf_hi(oo.w) + bf_hi(gg.w) * v1[3]);
                    *(u32x4*)(Mg + off) = w; }
            asm volatile("" ::: "memory"); }
    }
};
struct EpiResid {
    static constexpr bool PERM = false, AFTER_DRAIN = false;
    const float* res; float* out; float alpha;
    __device__ __forceinline__ void operator()(const f32x4 (&acc)[2][2][4][2], const Unit& u, int wr, int wc, int fr, int fq) const {
        const size_t off0 = (size_t)(u.pm * BM + wr * 64 + fr) * 1024 + u.pn * BM + wc * 32 + 4 * fq;
#pragma unroll
        for (int ai = 0; ai < 2; ++ai) {
            f32x4 r[4][2][2];
#pragma unroll
            for (int m = 0; m < 4; ++m)
#pragma unroll
                for (int bj = 0; bj < 2; ++bj)
#pragma unroll
                    for (int n = 0; n < 2; ++n) r[m][bj][n] = *(const f32x4*)(res + off0 + (size_t)(ai * HALF + m * 16) * 1024 + bj * HALF + n * 16);
#pragma unroll
            for (int m = 0; m < 4; ++m)
#pragma unroll
                for (int bj = 0; bj < 2; ++bj)
#pragma unroll
                    for (int n = 0; n < 2; ++n) *(f32x4*)(out + off0 + (size_t)(ai * HALF + m * 16) * 1024 + bj * HALF + n * 16) = r[m][bj][n] * alpha + acc[ai][bj][m][n];
            asm volatile("" ::: "memory"); }
    }
};
struct EpiSwiglu {
    static constexpr bool PERM = true, AFTER_DRAIN = false;
    bf16_t* H; size_t pstride;
    __device__ __forceinline__ void operator()(const f32x4 (&acc)[2][2][4][2], const Unit& u, int wr, int wc, int fr, int fq) const {
        bf16_t* base = H + (size_t)u.pm * pstride + (size_t)(wr * 64 + fr) * 2816 + u.pn * HALF + wc * 32 + 8 * fq;
#pragma unroll
        for (int ai = 0; ai < 2; ++ai)
#pragma unroll
            for (int m = 0; m < 4; ++m) { float hv[8];
#pragma unroll
                for (int n = 0; n < 2; ++n)
#pragma unroll
                    for (int i = 0; i < 4; ++i) { const float gt = acc[ai][0][m][n][i], up = acc[ai][1][m][n][i]; hv[n * 4 + i] = gt * sigmoidf_(gt) * up; }
                u32x4 w; w.x = cvt_pk_bf16(hv[0], hv[1]); w.y = cvt_pk_bf16(hv[2], hv[3]); w.z = cvt_pk_bf16(hv[4], hv[5]); w.w = cvt_pk_bf16(hv[6], hv[7]);
                *(u32x4*)(base + (size_t)(ai * HALF + m * 16) * 2816) = w; }
    }
};

template <class Epi, class Sched, bool ALIGN_EPI = false, bool SP2 = false>
__device__ __forceinline__ void gemm_phase(PG8_LAS unsigned char* lds, const Gemm g, const Sched& S, const Epi& E) {
    int tid_ = threadIdx.x; asm volatile("" : "+v"(tid_));
    const int tid = tid_, wid = __builtin_amdgcn_readfirstlane(tid >> 6), lane = tid & 63, wr = wid >> 2, wc = wid & 3, fr = lane & 15, fq = lane >> 4;
    const int K = g.K, nt = K / BK;
    unsigned voffA[2], voffB[2];
#pragma unroll
    for (int i = 0; i < 2; ++i) { int R, C; stage_rc(tid * 16 + i * 8192, R, C); const int Rb = Epi::PERM ? ((R & ~31) + perm32(R & 31)) : R;
        voffA[i] = (unsigned)(R * g.lda + C) * 2u; voffB[i] = (unsigned)(Rb * K + C) * 2u; }
    const size_t kstep = (size_t)(BK * 2);
    const size_t hstepA = (size_t)HALF * g.lda * 2, hstepB = (size_t)HALF * K * 2;
    const size_t tstepA = g.apstride, tstepB = 2 * hstepB;
    const unsigned ldsw = (unsigned)wid * 1024u;
    const int aoff = lds_byte(wr * 64 + fr, fq * 8), boff = lds_byte(wc * 32 + fr, fq * 8);
#define PG8_SA(b, h) (((b) * 2 + (h)) * HTB)
#define PG8_SB(b, h) ((4 + (b) * 2 + (h)) * HTB)
#define PG8_STAGE(bufoff, gbase, voff) do { _Pragma("unroll") for (int _i = 0; _i < 2; ++_i) \
        __builtin_amdgcn_global_load_lds((const unsigned*)((const char*)(gbase) + (voff)[_i]), (PG8_LAS unsigned*)(lds + (bufoff) + ldsw + _i * 8192), 16, 0, 0); } while (0)
#define PG8_LDA(dst, b, h) do { _Pragma("unroll") for (int m = 0; m < 4; ++m) _Pragma("unroll") for (int k = 0; k < 2; ++k) dst[m][k] = *(const PG8_LAS bf16x8*)(lds + PG8_SA(b, h) + aoff + m * 2048 + k * 1024); } while (0)
#define PG8_LDB(dst, b, h) do { _Pragma("unroll") for (int n = 0; n < 2; ++n) _Pragma("unroll") for (int k = 0; k < 2; ++k) dst[n][k] = *(const PG8_LAS bf16x8*)(lds + PG8_SB(b, h) + boff + n * 2048 + k * 1024); } while (0)
#define PG8_MMA(ai, bj, At, Bt) do { __builtin_amdgcn_s_setprio(1); _Pragma("unroll") for (int m = 0; m < 4; ++m) _Pragma("unroll") for (int n = 0; n < 2; ++n) _Pragma("unroll") for (int k = 0; k < 2; ++k) \
        acc[ai][bj][m][n] = __builtin_amdgcn_mfma_f32_16x16x32_bf16(Bt[n][k], At[m][k], acc[ai][bj][m][n], 0, 0, 0); __builtin_amdgcn_s_setprio(0); } while (0)
#define PG8_WAIT_V(n) asm volatile("s_waitcnt vmcnt(" #n ")" ::: "memory")
#define PG8_WAIT_L(n) asm volatile("s_waitcnt lgkmcnt(" #n ")" ::: "memory")
#define PG8_BAR __builtin_amdgcn_s_barrier()
#define PG8_SCHED __builtin_amdgcn_sched_barrier(0)
    Unit cur, nxt; int ui = 0;
    if (!S.next(0, cur)) return;
    f32x4 acc[2][2][4][2];
#pragma unroll
    for (int a = 0; a < 2; ++a)
#pragma unroll
        for (int b = 0; b < 2; ++b)
#pragma unroll
            for (int m = 0; m < 4; ++m)
#pragma unroll
                for (int n = 0; n < 2; ++n) acc[a][b][m][n] = (f32x4){0.f, 0.f, 0.f, 0.f};
    bf16x8 At[4][2], B0[2][2], B1[2][2];
    const char* cA = (const char*)g.A + (size_t)cur.pm * tstepA; const char* cB = (const char*)g.Bt + (size_t)cur.pn * tstepB;
    S.a_ready(cur);
    if constexpr (SP2) {
        PG8_STAGE(PG8_SB(0, 0), cB, voffB); PG8_STAGE(PG8_SB(0, 1), cB + hstepB, voffB); PG8_STAGE(PG8_SA(0, 0), cA, voffA); PG8_STAGE(PG8_SA(0, 1), cA + hstepA, voffA);
        if (wr == 1) PG8_BAR;
        PG8_WAIT_V(2); PG8_BAR;
        PG8_STAGE(PG8_SB(1, 0), cB + kstep, voffB); PG8_STAGE(PG8_SA(1, 0), cA + kstep, voffA); PG8_STAGE(PG8_SB(1, 1), cB + hstepB + kstep, voffB);
        PG8_WAIT_V(6); PG8_BAR;
    } else {
        PG8_STAGE(PG8_SB(0, 0), cB, voffB); PG8_STAGE(PG8_SA(0, 0), cA, voffA); PG8_STAGE(PG8_SB(0, 1), cB + hstepB, voffB); PG8_STAGE(PG8_SA(0, 1), cA + hstepA, voffA);
        if (wr == 1) PG8_BAR;
        PG8_WAIT_V(4); PG8_BAR;
        PG8_STAGE(PG8_SB(1, 0), cB + kstep, voffB); PG8_STAGE(PG8_SA(1, 0), cA + kstep, voffA); PG8_STAGE(PG8_SB(1, 1), cB + hstepB + kstep, voffB);
        PG8_WAIT_V(6); PG8_BAR;
    }
    for (;;) {
        const bool has_next = S.next(ui + 1, nxt);
        const char* nA = has_next ? (const char*)g.A + (size_t)nxt.pm * tstepA : cA; const char* nB = has_next ? (const char*)g.Bt + (size_t)nxt.pn * tstepB : cB;
        for (int t = 0; t < nt; t += 2) {
            const bool last = (t == nt - 2);
            const char* a1 = cA + (size_t)(t + 1) * kstep;
            const char* a2 = last ? nA : cA + (size_t)(t + 2) * kstep; const char* b2 = last ? nB : cB + (size_t)(t + 2) * kstep;
            const char* a3 = a2 + kstep; const char* b3 = b2 + kstep;
            if (last && has_next) S.a_ready(nxt);
            if constexpr (SP2) {
            PG8_LDB(B0, 0, 0); PG8_LDB(B1, 0, 1); PG8_SCHED; PG8_LDA(At, 0, 0); PG8_STAGE(PG8_SA(1, 1), a1 + hstepA, voffA);
            PG8_WAIT_V(8); PG8_WAIT_L(0); PG8_BAR; PG8_MMA(0, 0, At, B0); PG8_MMA(0, 1, At, B1); PG8_BAR; PG8_SCHED;
            PG8_LDA(At, 0, 1); PG8_STAGE(PG8_SB(0, 0), b2, voffB); PG8_STAGE(PG8_SB(0, 1), b2 + hstepB, voffB); PG8_STAGE(PG8_SA(0, 0), a2, voffA);
            PG8_WAIT_V(8); PG8_WAIT_L(0); PG8_BAR; PG8_MMA(1, 0, At, B0); PG8_MMA(1, 1, At, B1); PG8_BAR; PG8_SCHED;
            PG8_LDB(B0, 1, 0); PG8_LDB(B1, 1, 1); PG8_SCHED; PG8_LDA(At, 1, 0); PG8_STAGE(PG8_SA(0, 1), a2 + hstepA, voffA);
            PG8_WAIT_V(8); PG8_WAIT_L(0); PG8_BAR; PG8_MMA(0, 0, At, B0); PG8_MMA(0, 1, At, B1); PG8_BAR; PG8_SCHED;
            PG8_LDA(At, 1, 1); PG8_STAGE(PG8_SB(1, 0), b3, voffB); PG8_STAGE(PG8_SB(1, 1), b3 + hstepB, voffB); PG8_STAGE(PG8_SA(1, 0), a3, voffA);
            PG8_WAIT_V(8); PG8_WAIT_L(0); PG8_BAR; PG8_MMA(1, 0, At, B0); PG8_MMA(1, 1, At, B1); PG8_BAR; PG8_SCHED;
            } else {
            PG8_LDB(B0, 0, 0); PG8_SCHED; PG8_LDA(At, 0, 0); PG8_STAGE(PG8_SA(1, 1), a1 + hstepA, voffA);
            PG8_WAIT_L(8); PG8_BAR; PG8_WAIT_L(0); PG8_MMA(0, 0, At, B0); PG8_BAR; PG8_SCHED;
            PG8_LDB(B1, 0, 1); PG8_STAGE(PG8_SB(0, 0), b2, voffB);
            PG8_BAR; PG8_WAIT_L(0); PG8_MMA(0, 1, At, B1); PG8_BAR;
            PG8_LDA(At, 0, 1); PG8_STAGE(PG8_SA(0, 0), a2, voffA);
            PG8_BAR; PG8_WAIT_L(0); PG8_MMA(1, 0, At, B0); PG8_BAR; PG8_SCHED;
            PG8_STAGE(PG8_SB(0, 1), b2 + hstepB, voffB);
            PG8_WAIT_V(6); PG8_BAR; PG8_MMA(1, 1, At, B1); PG8_BAR;
            PG8_LDB(B0, 1, 0); PG8_SCHED; PG8_LDA(At, 1, 0); PG8_STAGE(PG8_SA(0, 1), a2 + hstepA, voffA);
            PG8_WAIT_L(8); PG8_BAR; PG8_WAIT_L(0); PG8_MMA(0, 0, At, B0); PG8_BAR; PG8_SCHED;
            PG8_LDB(B1, 1, 1); PG8_STAGE(PG8_SB(1, 0), b3, voffB);
            PG8_BAR; PG8_WAIT_L(0); PG8_MMA(0, 1, At, B1); PG8_BAR;
            PG8_LDA(At, 1, 1); PG8_STAGE(PG8_SA(1, 0), a3, voffA);
            PG8_BAR; PG8_WAIT_L(0); PG8_MMA(1, 0, At, B0); PG8_BAR; PG8_SCHED;
            PG8_STAGE(PG8_SB(1, 1), b3 + hstepB, voffB);
            PG8_WAIT_V(6); PG8_BAR; PG8_MMA(1, 1, At, B1); PG8_BAR;
            }
        }
        if constexpr (ALIGN_EPI) { if (wr == 0) PG8_BAR; }
        if constexpr (!Epi::AFTER_DRAIN) { E(acc, cur, wr, wc, fr, fq); S.done(cur); }
        if (!has_next) break;
#pragma unroll
        for (int a = 0; a < 2; ++a)
#pragma unroll
            for (int b = 0; b < 2; ++b)
#pragma unroll
                for (int m = 0; m < 4; ++m)
#pragma unroll
                    for (int n = 0; n < 2; ++n) acc[a][b][m][n] = (f32x4){0.f, 0.f, 0.f, 0.f};
        cur = nxt; cA = nA; cB = nB; ++ui;
        if constexpr (ALIGN_EPI) { if (wr == 1) PG8_BAR; }
    }
    PG8_WAIT_V(0);
    if constexpr (!ALIGN_EPI) { if (wr == 0) PG8_BAR; }
    PG8_BAR;
    if constexpr (Epi::AFTER_DRAIN) { E.fused(acc, cur, wr, wc, fr, fq, lds, wid, lane); S.done(cur); }
#undef PG8_SA
#undef PG8_SB
#undef PG8_STAGE
#undef PG8_LDA
#undef PG8_LDB
#undef PG8_MMA
#undef PG8_WAIT_V
#undef PG8_WAIT_L
#undef PG8_BAR
#undef PG8_SCHED
}
}

#define LAS __attribute__((address_space(3)))
typedef unsigned short bf16;
typedef short bf16x8 __attribute__((ext_vector_type(8)));
typedef short s16x4 __attribute__((ext_vector_type(4)));
typedef float f32x4 __attribute__((ext_vector_type(4)));
typedef float f32x16 __attribute__((ext_vector_type(16)));
typedef unsigned u32x4 __attribute__((ext_vector_type(4)));
typedef unsigned u32x2 __attribute__((ext_vector_type(2)));
typedef float f32x2v __attribute__((ext_vector_type(2)));

constexpr int BATCH = 8, SEQ = 8192, DM = 1024, MTOK = BATCH * SEQ, NPANEL = MTOK / 256, PW = 6912, PA = 3840, FF = 2816, NLAYER = 2;
constexpr float LOG2E = 1.4426950408889634f, LN_EPS = 1e-5f, ALPHA_DN = 1.4142135623730951f;
constexpr int C_AQ = 0, C_AK = 512, C_AV = 640, C_BH = 768, C_BB = 1280, C_BC = 1792, C_CQ = 2304, C_CK = 2816, C_CV = 3328;
constexpr size_t MiB = 1u << 20;
constexpr size_t LW_IN = 0, LW_BR = 14 * MiB, LW_OUT = 17 * MiB, LW_GU = 19 * MiB, LW_DN = 30 * MiB, LW_SIZE = 36 * MiB;
constexpr size_t WS_W = 1 * MiB, WS_XB = WS_W + 2 * LW_SIZE, WS_QKV = WS_XB + 128 * MiB, WS_Y = WS_QKV + 480 * MiB, WS_KMEAN = WS_Y + 192 * MiB, WS_KF = WS_KMEAN + 1 * MiB, WS_VF = WS_KF + 64 * MiB, WS_END = WS_VF + 64 * MiB;
constexpr size_t QKV_PSTR = (size_t)256 * PA;
constexpr size_t OV_G = 0, OV_MG = 256 * 1024, OV_H = 0, OV_D1 = 0  , OV_D2 = 256 * 2816  ;
constexpr int NWAVES = 8, NTHR = 512;
constexpr int LDS_BYTES = 131072 + 4096;
constexpr int MB_OP = 0, MB_OPROW = 136, MB_ML = 3 * 256 * MB_OPROW, MB_LIST = MB_ML + 3 * 256 * 8, MB_CNT = MB_LIST + 32 * 256, MB_SEL = MB_CNT + 128, MB_END = MB_SEL + 1024;
static_assert(MB_END <= 131072, "moba lds");
constexpr int AL_K0 = 0, AL_KSZ = 64 * 144, AL_V0 = 2 * AL_KSZ, AL_VSZ = 64 * 136, AL_KM = AL_V0 + 2 * AL_VSZ, AL_END = AL_KM + 8192;

__device__ __forceinline__ unsigned pk2(float lo, float hi) { return pg8::cvt_pk_bf16(lo, hi); }
__device__ __forceinline__ float bflo(unsigned u) { return __uint_as_float(u << 16); }
__device__ __forceinline__ float bfhi(unsigned u) { return __uint_as_float(u & 0xffff0000u); }
__device__ __forceinline__ float wave_sum(float v) {
#pragma unroll
    for (int o = 1; o < 64; o <<= 1) v += __shfl_xor(v, o);
    return v;
}
#define WG_BAR() __syncthreads()

__device__ __forceinline__ void transpose_item(const float* W, int K, int N, bf16* WT, int mode, LAS float* scr, int item, int lane) {
    const int nblk = N / 32, kb = item / nblk, nb = item % nblk, k0 = 64 * kb, n0 = 32 * nb;
    int r0 = n0;
    if (mode == 1) r0 = 256 * (n0 >> 7) + (n0 & 127);
    else if (mode == 2) r0 = 256 * (n0 >> 7) + 128 + (n0 & 127);
#pragma unroll 8
    for (int i = 0; i < 32; ++i) { const int kk = 2 * i + (lane >> 5); scr[kk * 33 + (lane & 31)] = W[(size_t)(k0 + kk) * N + n0 + (lane & 31)]; }
    asm volatile("s_waitcnt lgkmcnt(0)" ::: "memory");
    const int c = lane & 7;
#pragma unroll
    for (int j = 0; j < 4; ++j) { const int n = (lane >> 3) + 8 * j; const LAS float* s = scr + (8 * c) * 33 + n;
        u32x4 o; o.x = pk2(s[0 * 33], s[1 * 33]); o.y = pk2(s[2 * 33], s[3 * 33]); o.z = pk2(s[4 * 33], s[5 * 33]); o.w = pk2(s[6 * 33], s[7 * 33]);
        *(u32x4*)(WT + (size_t)(r0 + n) * K + k0 + 8 * c) = o; }
    asm volatile("s_waitcnt lgkmcnt(0)" ::: "memory");
}

__device__ __forceinline__ void ln_panel(int pm, const float* resf, const bf16* rlo, const bf16* dlt, float* xo, const float* gam, const float* bet, bf16* xb, bf16* wlo, bool fin, float alpha) {
    int tid = threadIdx.x; asm volatile("" : "+v"(tid)); const int lane = tid & 63, wave = __builtin_amdgcn_readfirstlane(tid >> 6);
    f32x4 gv[4], bv[4];
#pragma unroll
    for (int j = 0; j < 4; ++j) { gv[j] = *(const f32x4*)(gam + 4 * lane + 256 * j); bv[j] = *(const f32x4*)(bet + 4 * lane + 256 * j); }
#pragma unroll 4
    for (int r = wave * 32; r < wave * 32 + 32; ++r) {
        const size_t grow = (size_t)(pm * 256 + r) * DM + 4 * lane, prow = (size_t)r * DM + 4 * lane;
        f32x4 v[4]; float s = 0.f;
#pragma unroll
        for (int j = 0; j < 4; ++j) { f32x4 x; const u32x2 d = *(const u32x2*)(dlt + prow + 256 * j);
            if (resf) x = *(const f32x4*)(resf + grow + 256 * j);
            else { const u32x2 h = *(const u32x2*)(xb + grow + 256 * j), l = *(const u32x2*)(rlo + prow + 256 * j);
                   x = (f32x4){bflo(h.x) + bflo(l.x), bfhi(h.x) + bfhi(l.x), bflo(h.y) + bflo(l.y), bfhi(h.y) + bfhi(l.y)}; }
            v[j] = (f32x4){x.x * alpha + bflo(d.x), x.y * alpha + bfhi(d.x), x.z * alpha + bflo(d.y), x.w * alpha + bfhi(d.y)}; s += (v[j].x + v[j].y) + (v[j].z + v[j].w); }
        const float mean = wave_sum(s) * (1.f / DM); float s2 = 0.f;
#pragma unroll
        for (int j = 0; j < 4; ++j) { v[j] = v[j] - mean; s2 += (v[j].x * v[j].x + v[j].y * v[j].y) + (v[j].z * v[j].z + v[j].w * v[j].w); }
        const float rstd = 1.f / sqrtf(wave_sum(s2) * (1.f / DM) + LN_EPS);
#pragma unroll
        for (int j = 0; j < 4; ++j) { const f32x4 o = v[j] * rstd * gv[j] + bv[j];
            if (fin) *(f32x4*)(xo + grow + 256 * j) = o;
            else { u32x2 w; w.x = pk2(o.x, o.y); w.y = pk2(o.z, o.w); *(u32x2*)(xb + grow + 256 * j) = w;
                   u32x2 q; q.x = pk2(o.x - bflo(w.x), o.y - bfhi(w.x)); q.y = pk2(o.z - bflo(w.y), o.w - bfhi(w.y)); *(u32x2*)(wlo + prow + 256 * j) = q; } }
    }
}
__device__ __forceinline__ void cvt_panel(int pm, const float* x, bf16* xb) {
    int tid = threadIdx.x; asm volatile("" : "+v"(tid));
    const float* src = x + (size_t)pm * 256 * DM; bf16* dst = xb + (size_t)pm * 256 * DM;
#pragma unroll 4
    for (int i = tid; i < 256 * DM / 8; i += NTHR) { const f32x4 a = *(const f32x4*)(src + (size_t)i * 8), b = *(const f32x4*)(src + (size_t)i * 8 + 4);
        u32x4 w; w.x = pk2(a.x, a.y); w.y = pk2(a.z, a.w); w.z = pk2(b.x, b.y); w.w = pk2(b.z, b.w); *(u32x4*)(dst + (size_t)i * 8) = w; }
}
__device__ __forceinline__ void kmean_panel(int pm, const bf16* qkv, float* kmean, LAS float* scr) {
    int tid = threadIdx.x; asm volatile("" : "+v"(tid));
    const int cg8 = tid & 63, rg = tid >> 6; float s[8];
#pragma unroll
    for (int j = 0; j < 8; ++j) s[j] = 0.f;
    const bf16* p = qkv + (size_t)(pm * 256 + rg * 32) * PA + C_CK + 8 * cg8;
#pragma unroll 8
    for (int r = 0; r < 32; ++r) { const u32x4 v = *(const u32x4*)(p + (size_t)r * PA);
        s[0] += bflo(v.x); s[1] += bfhi(v.x); s[2] += bflo(v.y); s[3] += bfhi(v.y); s[4] += bflo(v.z); s[5] += bfhi(v.z); s[6] += bflo(v.w); s[7] += bfhi(v.w); }
#pragma unroll
    for (int j = 0; j < 8; ++j) scr[rg * 512 + 8 * cg8 + j] = s[j];
    WG_BAR();
    float t = 0.f;
#pragma unroll
    for (int g = 0; g < 8; ++g) t += scr[g * 512 + tid];
    const int b = pm >> 5, n = pm & 31, h = tid >> 6, d = tid & 63;
    kmean[((size_t)(b * 8 + h) * 32 + n) * 64 + d] = t * (1.f / 256.f);
    WG_BAR();
}

__device__ __forceinline__ void kvfrag_panel(int pm, const bf16* qkv, bf16* KF, bf16* VF, LAS unsigned char* lds) {
    int tid = threadIdx.x; asm volatile("" : "+v"(tid));
    const int lane = tid & 63, h = __builtin_amdgcn_readfirstlane(tid >> 6), r32 = lane & 31, hi = lane >> 5;
    const int b = pm >> 5, n = pm & 31;
    LAS unsigned short* vt = (LAS unsigned short*)(lds + h * 8704);
    u32x4 vr[2][8];
#define VF_LOAD(t, s) do { const bf16* vrow_ = qkv + (size_t)(pm * 256 + 64 * (t) + lane) * PA + C_CV + 64 * h; \
        _Pragma("unroll") for (int c = 0; c < 8; ++c) vr[s][c] = *(const u32x4*)(vrow_ + 8 * c); } while (0)
    VF_LOAD(0, 0);
#pragma unroll
    for (int t = 0; t < 4; ++t) {
        const int s = t & 1;
        if (t + 1 < 4) VF_LOAD(t + 1, s ^ 1);
        const size_t tile = ((size_t)(b * 8 + h) * 128 + n * 4 + t) * 4096;
#pragma unroll
        for (int c = 0; c < 8; ++c) { const u32x4 v = vr[s][c];
            LAS unsigned short* p = vt + (8 * c) * 68 + lane;
            p[0 * 68] = (unsigned short)(v.x & 0xffffu); p[1 * 68] = (unsigned short)(v.x >> 16); p[2 * 68] = (unsigned short)(v.y & 0xffffu); p[3 * 68] = (unsigned short)(v.y >> 16);
            p[4 * 68] = (unsigned short)(v.z & 0xffffu); p[5 * 68] = (unsigned short)(v.z >> 16); p[6 * 68] = (unsigned short)(v.w & 0xffffu); p[7 * 68] = (unsigned short)(v.w >> 16); }
        asm volatile("s_waitcnt lgkmcnt(0)" ::: "memory");
#pragma unroll
        for (int dh = 0; dh < 2; ++dh)
#pragma unroll
            for (int ks = 0; ks < 4; ++ks) {
                LAS const unsigned char* vp = (LAS const unsigned char*)vt + (32 * dh + r32) * 136 + hi * 8 + (32 * (ks >> 1) + 16 * (ks & 1)) * 2;
                const u32x2 lo = *(LAS const u32x2*)vp, hh = *(LAS const u32x2*)(vp + 16);
                *(u32x4*)(VF + tile + ((dh * 4 + ks) * 64 + lane) * 8) = (u32x4){lo.x, lo.y, hh.x, hh.y}; }
        asm volatile("s_waitcnt lgkmcnt(0)" ::: "memory");
    }
#undef VF_LOAD
}

struct Stage { u32x4 k, v; };
__device__ __forceinline__ void stage_ld(Stage& s, const bf16* Kg, const bf16* Vg, int key0, int tid) {
    const size_t o = (size_t)(key0 + (tid >> 3)) * PA + (tid & 7) * 8; s.k = *(const u32x4*)(Kg + o); s.v = *(const u32x4*)(Vg + o);
}
__device__ __forceinline__ void stage_st(const Stage& s, LAS unsigned char* Kb, LAS unsigned char* Vb, int tid) {
    const int key = tid >> 3, ch = tid & 7;
    *(LAS u32x4*)(Kb + key * 144 + ch * 16) = s.k;
    LAS unsigned short* vt = (LAS unsigned short*)Vb + (ch * 8) * 68 + key;
    vt[0 * 68] = (unsigned short)(s.v.x & 0xffffu); vt[1 * 68] = (unsigned short)(s.v.x >> 16);
    vt[2 * 68] = (unsigned short)(s.v.y & 0xffffu); vt[3 * 68] = (unsigned short)(s.v.y >> 16);
    vt[4 * 68] = (unsigned short)(s.v.z & 0xffffu); vt[5 * 68] = (unsigned short)(s.v.z >> 16);
    vt[6 * 68] = (unsigned short)(s.v.w & 0xffffu); vt[7 * 68] = (unsigned short)(s.v.w >> 16);
}
template <int MASK>
__device__ __forceinline__ void attn_tile(LAS const unsigned char* Kb, LAS const unsigned char* Vb, const bf16x8 (&qf)[4], f32x16& o0, f32x16& o1, float& m, float& l,
                                          int kq, float sl2, bool lane_ok, int r32, int hi) {
    f32x16 p0, p1;
#pragma unroll
    for (int r = 0; r < 16; ++r) { p0[r] = 0.f; p1[r] = 0.f; }
    LAS const unsigned char* kp = Kb + r32 * 144 + hi * 16;
#pragma unroll
    for (int d0 = 0; d0 < 4; ++d0) {
        const bf16x8 a0 = *(LAS const bf16x8*)(kp + d0 * 32), a1 = *(LAS const bf16x8*)(kp + 32 * 144 + d0 * 32);
        p0 = __builtin_amdgcn_mfma_f32_32x32x16_bf16(a0, qf[d0], p0, 0, 0, 0);
        p1 = __builtin_amdgcn_mfma_f32_32x32x16_bf16(a1, qf[d0], p1, 0, 0, 0);
    }
    constexpr float C2 = 0.125f * LOG2E;
    const int dk0 = kq + 4 * hi;
    const float base = sl2 * (float)dk0;
    const float NEG = -INFINITY;
    float mx = NEG;
#pragma unroll
    for (int r = 0; r < 16; ++r) {
        const int kk = (r & 3) + 8 * (r >> 2);
        float t0 = fmaf(p0[r], C2, fmaf((float)kk, sl2, base)), t1 = fmaf(p1[r], C2, fmaf((float)(kk + 32), sl2, base));
        if (MASK == 1) { if (dk0 + kk > 0) t0 = NEG; if (dk0 + kk + 32 > 0) t1 = NEG; }
        if (MASK == 2) { const int a = dk0 + kk, b = a + 32; if (a > 0 || a <= -128) t0 = NEG; if (b > 0 || b <= -128) t1 = NEG; }
        if (MASK == 0) { if (!lane_ok) { t0 = NEG; t1 = NEG; } }
        p0[r] = t0; p1[r] = t1; mx = fmaxf(mx, fmaxf(t0, t1));
    }
    mx = fmaxf(mx, __shfl_xor(mx, 32));
    const float mn = fmaxf(m, mx), alpha = __builtin_amdgcn_exp2f(m - mn); m = mn;
    float rs = 0.f;
#pragma unroll
    for (int r = 0; r < 16; ++r) { p0[r] = __builtin_amdgcn_exp2f(p0[r] - mn); p1[r] = __builtin_amdgcn_exp2f(p1[r] - mn); rs += p0[r] + p1[r]; }
    l = l * alpha + rs;
#pragma unroll
    for (int r = 0; r < 16; ++r) { o0[r] *= alpha; o1[r] *= alpha; }
    u32x4 pw[4];
    pw[0] = (u32x4){pk2(p0[0], p0[1]), pk2(p0[2], p0[3]), pk2(p0[4], p0[5]), pk2(p0[6], p0[7])};
    pw[1] = (u32x4){pk2(p0[8], p0[9]), pk2(p0[10], p0[11]), pk2(p0[12], p0[13]), pk2(p0[14], p0[15])};
    pw[2] = (u32x4){pk2(p1[0], p1[1]), pk2(p1[2], p1[3]), pk2(p1[4], p1[5]), pk2(p1[6], p1[7])};
    pw[3] = (u32x4){pk2(p1[8], p1[9]), pk2(p1[10], p1[11]), pk2(p1[12], p1[13]), pk2(p1[14], p1[15])};
    LAS const unsigned char* vp = Vb + r32 * 136 + hi * 8;
#pragma unroll
    for (int ks = 0; ks < 4; ++ks) {
        const int koff = (32 * (ks >> 1) + 16 * (ks & 1)) * 2;
        const s16x4 a0l = *(LAS const s16x4*)(vp + koff), a0h = *(LAS const s16x4*)(vp + koff + 16);
        const s16x4 a1l = *(LAS const s16x4*)(vp + 32 * 136 + koff), a1h = *(LAS const s16x4*)(vp + 32 * 136 + koff + 16);
        const bf16x8 A0 = (bf16x8){a0l[0], a0l[1], a0l[2], a0l[3], a0h[0], a0h[1], a0h[2], a0h[3]};
        const bf16x8 A1 = (bf16x8){a1l[0], a1l[1], a1l[2], a1l[3], a1h[0], a1h[1], a1h[2], a1h[3]};
        const bf16x8 P = __builtin_bit_cast(bf16x8, pw[ks]);
        o0 = __builtin_amdgcn_mfma_f32_32x32x16_bf16(A0, P, o0, 0, 0, 0);
        o1 = __builtin_amdgcn_mfma_f32_32x32x16_bf16(A1, P, o1, 0, 0, 0);
    }
}
__device__ __forceinline__ void attn_store(bf16* yrow, const f32x16& o0, const f32x16& o1, float inv, int hi) {
#pragma unroll
    for (int rg = 0; rg < 4; ++rg) {
        u32x2 w0, w1;
        w0.x = pk2(o0[4 * rg] * inv, o0[4 * rg + 1] * inv); w0.y = pk2(o0[4 * rg + 2] * inv, o0[4 * rg + 3] * inv);
        w1.x = pk2(o1[4 * rg] * inv, o1[4 * rg + 1] * inv); w1.y = pk2(o1[4 * rg + 2] * inv, o1[4 * rg + 3] * inv);
        *(u32x2*)(yrow + 8 * rg + 4 * hi) = w0; *(u32x2*)(yrow + 32 + 8 * rg + 4 * hi) = w1;
    }
}

template <int MASK>
__device__ __forceinline__ void attn_tile_fast(LAS const unsigned char* Kb, LAS const unsigned char* Vb, const bf16x8 (&qf)[4], const bf16x8& kx0, const bf16x8& kx1, const bf16x8& qx,
                                               f32x16& o0, f32x16& o1, float& m, float& l, int kq, float off, int r32, int hi) {
    f32x16 p0, p1;
#pragma unroll
    for (int r = 0; r < 16; ++r) { p0[r] = 0.f; p1[r] = 0.f; }
    p0 = __builtin_amdgcn_mfma_f32_32x32x16_bf16(kx0, qx, p0, 0, 0, 0);
    p1 = __builtin_amdgcn_mfma_f32_32x32x16_bf16(kx1, qx, p1, 0, 0, 0);
    LAS const unsigned char* kp = Kb + r32 * 144 + hi * 16;
#pragma unroll
    for (int d0 = 0; d0 < 4; ++d0) {
        const bf16x8 a0 = *(LAS const bf16x8*)(kp + d0 * 32), a1 = *(LAS const bf16x8*)(kp + 32 * 144 + d0 * 32);
        p0 = __builtin_amdgcn_mfma_f32_32x32x16_bf16(a0, qf[d0], p0, 0, 0, 0);
        p1 = __builtin_amdgcn_mfma_f32_32x32x16_bf16(a1, qf[d0], p1, 0, 0, 0);
    }
    constexpr float C2 = 0.125f * LOG2E;
    const float NEG = -INFINITY;
    if (MASK != 0) {
        const int dk0 = kq + 4 * hi;
#pragma unroll
        for (int r = 0; r < 16; ++r) { const int kk = (r & 3) + 8 * (r >> 2);
            if (MASK == 1) { if (dk0 > -kk) p0[r] = NEG; if (dk0 > -(kk + 32)) p1[r] = NEG; }
            if (MASK == 3) { if (dk0 <= -128 - kk) p0[r] = NEG; if (dk0 <= -160 - kk) p1[r] = NEG; } }
    }
    float mr = fmaxf(p0[0], p1[0]);
#pragma unroll
    for (int r = 1; r < 16; ++r) mr = fmaxf(fmaxf(mr, p0[r]), p1[r]);
    float mx = fmaf(mr, C2, off);
    mx = fmaxf(mx, __shfl_xor(mx, 32));
    const float mn = fmaxf(m, mx);
    if (__ballot(mn > m) != 0ull) {
        const float alpha = __builtin_amdgcn_exp2f(m - mn); l *= alpha;
#pragma unroll
        for (int r = 0; r < 16; ++r) { o0[r] *= alpha; o1[r] *= alpha; }
    }
    m = mn;
    const float sh = off - mn;
    float rs = 0.f;
#pragma unroll
    for (int r = 0; r < 16; ++r) { p0[r] = __builtin_amdgcn_exp2f(fmaf(p0[r], C2, sh)); p1[r] = __builtin_amdgcn_exp2f(fmaf(p1[r], C2, sh)); rs += p0[r] + p1[r]; }
    l += rs;
    u32x4 pw[4];
    pw[0] = (u32x4){pk2(p0[0], p0[1]), pk2(p0[2], p0[3]), pk2(p0[4], p0[5]), pk2(p0[6], p0[7])};
    pw[1] = (u32x4){pk2(p0[8], p0[9]), pk2(p0[10], p0[11]), pk2(p0[12], p0[13]), pk2(p0[14], p0[15])};
    pw[2] = (u32x4){pk2(p1[0], p1[1]), pk2(p1[2], p1[3]), pk2(p1[4], p1[5]), pk2(p1[6], p1[7])};
    pw[3] = (u32x4){pk2(p1[8], p1[9]), pk2(p1[10], p1[11]), pk2(p1[12], p1[13]), pk2(p1[14], p1[15])};
    LAS const unsigned char* vp = Vb + r32 * 136 + hi * 8;
#pragma unroll
    for (int ks = 0; ks < 4; ++ks) {
        const int koff = (32 * (ks >> 1) + 16 * (ks & 1)) * 2;
        const s16x4 a0l = *(LAS const s16x4*)(vp + koff), a0h = *(LAS const s16x4*)(vp + koff + 16);
        const s16x4 a1l = *(LAS const s16x4*)(vp + 32 * 136 + koff), a1h = *(LAS const s16x4*)(vp + 32 * 136 + koff + 16);
        const bf16x8 A0 = (bf16x8){a0l[0], a0l[1], a0l[2], a0l[3], a0h[0], a0h[1], a0h[2], a0h[3]};
        const bf16x8 A1 = (bf16x8){a1l[0], a1l[1], a1l[2], a1l[3], a1h[0], a1h[1], a1h[2], a1h[3]};
        const bf16x8 P = __builtin_bit_cast(bf16x8, pw[ks]);
        o0 = __builtin_amdgcn_mfma_f32_32x32x16_bf16(A0, P, o0, 0, 0, 0);
        o1 = __builtin_amdgcn_mfma_f32_32x32x16_bf16(A1, P, o1, 0, 0, 0);
    }
}
__device__ __forceinline__ void swa_phase(int first, int stride, const bf16* qkv, bf16* Y, const float* sinks, LAS unsigned char* lds) {
    int tid = threadIdx.x; asm volatile("" : "+v"(tid));
    const int lane = tid & 63, wave = tid >> 6, r32 = lane & 31, hi = lane >> 5;
    constexpr int SV0 = 3 * AL_KSZ;
    Stage st[3];
    int u = first;
    if (u < 2048) { const int tb = u & 127, kvh = (u >> 7) & 1, b = u >> 8; const int nt = (tb + 1 < 3) ? tb + 1 : 3;
        const bf16* Kg = qkv + (size_t)b * SEQ * PA + C_AK + kvh * 64; const bf16* Vg = qkv + (size_t)b * SEQ * PA + C_AV + kvh * 64;
#pragma unroll
        for (int i = 0; i < 3; ++i) if (i < nt) stage_ld(st[i], Kg, Vg, 64 * (tb - i), tid); }
    for (; u < 2048; u += stride) {
        const int tb = u & 127, kvh = (u >> 7) & 1, b = u >> 8; const int nt = (tb + 1 < 3) ? tb + 1 : 3;
        const int head = 4 * kvh + (wave >> 1), qtok = 64 * tb + 32 * (wave & 1) + r32;
        const size_t row = (size_t)b * SEQ + qtok;
#pragma unroll
        for (int i = 0; i < 3; ++i) if (i < nt) stage_st(st[i], lds + i * AL_KSZ, lds + SV0 + i * AL_VSZ, tid);
        bf16x8 qf[4];
        { const bf16* qp = qkv + row * PA + C_AQ + head * 64 + hi * 8;
#pragma unroll
          for (int d0 = 0; d0 < 4; ++d0) qf[d0] = *(const bf16x8*)(qp + 16 * d0); }
        WG_BAR();
        { const int un = u + stride;
          if (un < 2048) { const int tb2 = un & 127, kvh2 = (un >> 7) & 1, b2 = un >> 8; const int nt2 = (tb2 + 1 < 3) ? tb2 + 1 : 3;
            const bf16* Kg = qkv + (size_t)b2 * SEQ * PA + C_AK + kvh2 * 64; const bf16* Vg = qkv + (size_t)b2 * SEQ * PA + C_AV + kvh2 * 64;
#pragma unroll
            for (int i = 0; i < 3; ++i) if (i < nt2) stage_ld(st[i], Kg, Vg, 64 * (tb2 - i), tid); } }
        const float sl2 = exp2f(-0.5f * (float)(head + 1)) * LOG2E;
        float m = sinks[head] * LOG2E, l = (hi == 0) ? 1.f : 0.f;
        f32x16 o0, o1;
#pragma unroll
        for (int r = 0; r < 16; ++r) { o0[r] = 0.f; o1[r] = 0.f; }
        bf16x8 kx0, kx1, qx;
        { const float xs = sl2 * (1.f / (0.125f * LOG2E)); const unsigned shb = pk2(xs, 0.f) & 0xffffu; const float res = xs - __uint_as_float(shb << 16);
          const unsigned qw = (hi == 0) ? (shb | (pk2(res, 0.f) << 16)) : 0u;
          const unsigned k0w = (hi == 0) ? pk2((float)r32, (float)r32) : 0u, k1w = (hi == 0) ? pk2((float)(r32 + 32), (float)(r32 + 32)) : 0u;
          qx = __builtin_bit_cast(bf16x8, (u32x4){qw, 0u, 0u, 0u}); kx0 = __builtin_bit_cast(bf16x8, (u32x4){k0w, 0u, 0u, 0u}); kx1 = __builtin_bit_cast(bf16x8, (u32x4){k1w, 0u, 0u, 0u}); }
        { const int kq = 64 * tb - qtok; attn_tile_fast<1>(lds, lds + SV0, qf, kx0, kx1, qx, o0, o1, m, l, kq, sl2 * (float)kq, r32, hi); }
        if (nt > 1) { const int kq = 64 * (tb - 1) - qtok; attn_tile_fast<0>(lds + AL_KSZ, lds + SV0 + AL_VSZ, qf, kx0, kx1, qx, o0, o1, m, l, kq, sl2 * (float)kq, r32, hi); }
        if (nt > 2) { const int kq = 64 * (tb - 2) - qtok; attn_tile_fast<3>(lds + 2 * AL_KSZ, lds + SV0 + 2 * AL_VSZ, qf, kx0, kx1, qx, o0, o1, m, l, kq, sl2 * (float)kq, r32, hi); }
        const float lt = l + __shfl_xor(l, 32);
        attn_store(Y + row * 1536 + head * 64, o0, o1, 1.f / lt, hi);
        WG_BAR();
    }
}

struct KFr { bf16x8 a[2][4]; };
struct VFr { bf16x8 a[2][4]; };
__device__ __forceinline__ void loadK(KFr& f, const char*& p) {
#pragma unroll
    for (int kh = 0; kh < 2; ++kh) {
#pragma unroll
        for (int d0 = 0; d0 < 4; ++d0) f.a[kh][d0] = *(const bf16x8*)(p + d0 * 1024);
        p += 4096; asm volatile("" : "+v"(p));
    }
}
__device__ __forceinline__ void loadV(VFr& f, const char*& p) {
#pragma unroll
    for (int dh = 0; dh < 2; ++dh) {
#pragma unroll
        for (int ks = 0; ks < 4; ++ks) f.a[dh][ks] = *(const bf16x8*)(p + ks * 1024);
        p += 4096; asm volatile("" : "+v"(p));
    }
}
template <int MASK>
__device__ __forceinline__ void tile_qk(const KFr& f, const bf16x8 (&qf)[4], u32x4 (&pw)[4], f32x16& o0, f32x16& o1, float& m, float& l, int kq, float sl2, int lane) {
    const int hi = lane >> 5;
    f32x16 p0, p1;
#pragma unroll
    for (int r = 0; r < 16; ++r) { p0[r] = 0.f; p1[r] = 0.f; }
#pragma unroll
    for (int d0 = 0; d0 < 4; ++d0) {
        p0 = __builtin_amdgcn_mfma_f32_32x32x16_bf16(f.a[0][d0], qf[d0], p0, 0, 0, 0);
        p1 = __builtin_amdgcn_mfma_f32_32x32x16_bf16(f.a[1][d0], qf[d0], p1, 0, 0, 0);
    }
    constexpr float C2 = 0.125f * LOG2E;
    const int dk0 = kq + 4 * hi;
    float sl = sl2; asm volatile("" : "+v"(sl));
    const float base = sl * (float)dk0;
    const float NEG = -INFINITY;
    float mx = NEG;
#pragma unroll
    for (int r = 0; r < 16; ++r) {
        const int kk = (r & 3) + 8 * (r >> 2);
        float t0 = fmaf(p0[r], C2, fmaf((float)kk, sl, base)), t1 = fmaf(p1[r], C2, fmaf((float)(kk + 32), sl, base));
        if (MASK == 1) { if (dk0 + kk > 0) t0 = NEG; if (dk0 + kk + 32 > 0) t1 = NEG; }
        p0[r] = t0; p1[r] = t1; mx = fmaxf(mx, fmaxf(t0, t1));
    }
    mx = fmaxf(mx, __shfl_xor(mx, 32));
    const float mn = fmaxf(m, mx), alpha = __builtin_amdgcn_exp2f(m - mn); m = mn;
    float rs = 0.f;
#pragma unroll
    for (int r = 0; r < 16; ++r) { p0[r] = __builtin_amdgcn_exp2f(p0[r] - mn); p1[r] = __builtin_amdgcn_exp2f(p1[r] - mn); rs += p0[r] + p1[r]; }
    l = l * alpha + rs;
#pragma unroll
    for (int r = 0; r < 16; ++r) { o0[r] *= alpha; o1[r] *= alpha; }
    pw[0] = (u32x4){pk2(p0[0], p0[1]), pk2(p0[2], p0[3]), pk2(p0[4], p0[5]), pk2(p0[6], p0[7])};
    pw[1] = (u32x4){pk2(p0[8], p0[9]), pk2(p0[10], p0[11]), pk2(p0[12], p0[13]), pk2(p0[14], p0[15])};
    pw[2] = (u32x4){pk2(p1[0], p1[1]), pk2(p1[2], p1[3]), pk2(p1[4], p1[5]), pk2(p1[6], p1[7])};
    pw[3] = (u32x4){pk2(p1[8], p1[9]), pk2(p1[10], p1[11]), pk2(p1[12], p1[13]), pk2(p1[14], p1[15])};
}
__device__ __forceinline__ void tile_qk_fast(const KFr& f, const bf16x8 (&qf)[4], const bf16x8& kx0, const bf16x8& kx1, const bf16x8& qx, u32x4 (&pw)[4],
                                             f32x16& o0, f32x16& o1, float& m, float& l, float off) {
    f32x16 p0, p1;
#pragma unroll
    for (int r = 0; r < 16; ++r) { p0[r] = 0.f; p1[r] = 0.f; }
    p0 = __builtin_amdgcn_mfma_f32_32x32x16_bf16(kx0, qx, p0, 0, 0, 0);
    p1 = __builtin_amdgcn_mfma_f32_32x32x16_bf16(kx1, qx, p1, 0, 0, 0);
#pragma unroll
    for (int d0 = 0; d0 < 4; ++d0) {
        p0 = __builtin_amdgcn_mfma_f32_32x32x16_bf16(f.a[0][d0], qf[d0], p0, 0, 0, 0);
        p1 = __builtin_amdgcn_mfma_f32_32x32x16_bf16(f.a[1][d0], qf[d0], p1, 0, 0, 0);
    }
    constexpr float C2 = 0.125f * LOG2E;
    float mr = fmaxf(p0[0], p1[0]);
#pragma unroll
    for (int r = 1; r < 16; ++r) mr = fmaxf(fmaxf(mr, p0[r]), p1[r]);
    float mx = fmaf(mr, C2, off);
    mx = fmaxf(mx, __shfl_xor(mx, 32));
    const float mn = fmaxf(m, mx);
    if (__ballot(mn > m) != 0ull) {
        const float alpha = __builtin_amdgcn_exp2f(m - mn); l *= alpha;
#pragma unroll
        for (int r = 0; r < 16; ++r) { o0[r] *= alpha; o1[r] *= alpha; }
    }
    m = mn;
    const float sh = off - mn;
    float rs = 0.f;
#pragma unroll
    for (int r = 0; r < 16; ++r) { p0[r] = __builtin_amdgcn_exp2f(fmaf(p0[r], C2, sh)); p1[r] = __builtin_amdgcn_exp2f(fmaf(p1[r], C2, sh)); rs += p0[r] + p1[r]; }
    l += rs;
    pw[0] = (u32x4){pk2(p0[0], p0[1]), pk2(p0[2], p0[3]), pk2(p0[4], p0[5]), pk2(p0[6], p0[7])};
    pw[1] = (u32x4){pk2(p0[8], p0[9]), pk2(p0[10], p0[11]), pk2(p0[12], p0[13]), pk2(p0[14], p0[15])};
    pw[2] = (u32x4){pk2(p1[0], p1[1]), pk2(p1[2], p1[3]), pk2(p1[4], p1[5]), pk2(p1[6], p1[7])};
    pw[3] = (u32x4){pk2(p1[8], p1[9]), pk2(p1[10], p1[11]), pk2(p1[12], p1[13]), pk2(p1[14], p1[15])};
}
__device__ __forceinline__ void tile_pv(const VFr& f, const u32x4 (&pw)[4], f32x16& o0, f32x16& o1) {
#pragma unroll
    for (int ks = 0; ks < 4; ++ks) {
        const bf16x8 P = __builtin_bit_cast(bf16x8, pw[ks]);
        o0 = __builtin_amdgcn_mfma_f32_32x32x16_bf16(f.a[0][ks], P, o0, 0, 0, 0);
        o1 = __builtin_amdgcn_mfma_f32_32x32x16_bf16(f.a[1][ks], P, o1, 0, 0, 0);
    }
}

__device__ __forceinline__ void moba_unit(int b, int h, int qb, const bf16* qkv, const bf16* KF, const bf16* VF, bf16* Y, const float* kmean, LAS unsigned char* lds) {
    const bf16* KFh = KF + (size_t)(b * 8 + h) * 128 * 4096; const bf16* VFh = VF + (size_t)(b * 8 + h) * 128 * 4096;
    LAS unsigned* CNT = (LAS unsigned*)(lds + MB_CNT); LAS unsigned char* LIST = lds + MB_LIST; LAS unsigned* SEL = (LAS unsigned*)(lds + MB_SEL);
    {
    int tid = threadIdx.x; asm volatile("" : "+v"(tid));
    const int lane = tid & 63, wave = __builtin_amdgcn_readfirstlane(tid >> 6), r32 = lane & 31, hi = lane >> 5;
    const int qloc = 32 * wave + r32, qtok = 256 * qb + qloc;
    const size_t row = (size_t)b * SEQ + qtok;
    bf16x8 qf[4];
    { const bf16* qp = qkv + row * PA + C_CQ + h * 64 + hi * 8;
#pragma unroll
      for (int d0 = 0; d0 < 4; ++d0) qf[d0] = *(const bf16x8*)(qp + 16 * d0); }
    LAS float* KM = (LAS float*)(lds + MB_OP);
    { const f32x4* src = (const f32x4*)(kmean + (size_t)(b * 8 + h) * 32 * 64); for (int i = tid; i < qb * 16; i += NTHR) *(LAS f32x4*)(KM + 4 * i) = src[i]; }
    if (tid < 32) CNT[tid] = 0u;
    WG_BAR();
    unsigned selmask = 0u;
    {
        float v1 = -INFINITY, v2 = -INFINITY, v3 = -INFINITY; int i1 = 0, i2 = 0, i3 = 0;
        for (int n = 0; n < qb; ++n) {
            float part = 0.f;
#pragma unroll
            for (int d0 = 0; d0 < 4; ++d0) {
                const f32x4 ka = *(LAS const f32x4*)(KM + n * 64 + 16 * d0 + 8 * hi), kb = *(LAS const f32x4*)(KM + n * 64 + 16 * d0 + 8 * hi + 4);
                const u32x4 q = __builtin_bit_cast(u32x4, qf[d0]);
                part += bflo(q.x) * ka.x + bfhi(q.x) * ka.y + bflo(q.y) * ka.z + bfhi(q.y) * ka.w + bflo(q.z) * kb.x + bfhi(q.z) * kb.y + bflo(q.w) * kb.z + bfhi(q.w) * kb.w;
            }
            const float g = part + __shfl_xor(part, 32);
            if (g > v1) { v3 = v2; i3 = i2; v2 = v1; i2 = i1; v1 = g; i1 = n; }
            else if (g > v2) { v3 = v2; i3 = i2; v2 = g; i2 = n; }
            else if (g > v3) { v3 = g; i3 = n; }
        }
        if (v1 > -INFINITY) selmask |= 1u << i1;
        if (v2 > -INFINITY) selmask |= 1u << i2;
        if (v3 > -INFINITY) selmask |= 1u << i3;
    }
    WG_BAR();
    if (hi == 0) {
        SEL[qloc] = selmask;
        unsigned mm = selmask;
        while (mm) { const int n = __builtin_ctz(mm); mm &= mm - 1u;
            const unsigned pos = __hip_atomic_fetch_add(CNT + n, 1u, __ATOMIC_RELAXED, __HIP_MEMORY_SCOPE_WORKGROUP);
            LIST[n * 256 + pos] = (unsigned char)qloc; }
    }
    WG_BAR();
    }
    const float sl2 = exp2f(-0.5f * (float)(h + 9)) * LOG2E;
    {
        int tb_ = threadIdx.x; asm volatile("" : "+v"(tb_));
        const int lane = tb_ & 63, wave = __builtin_amdgcn_readfirstlane(tb_ >> 6), r32 = lane & 31, hi = lane >> 5;
        bf16x8 kx0, kx1, qx;
        { const float xs = sl2 * (1.f / (0.125f * LOG2E)); const unsigned shb = pk2(xs, 0.f) & 0xffffu; const float res = xs - __uint_as_float(shb << 16);
          const unsigned qw = (hi == 0) ? (shb | (pk2(res, 0.f) << 16)) : 0u;
          const unsigned k0w = (hi == 0) ? pk2((float)r32, (float)r32) : 0u, k1w = (hi == 0) ? pk2((float)(r32 + 32), (float)(r32 + 32)) : 0u;
          qx = __builtin_bit_cast(bf16x8, (u32x4){qw, 0u, 0u, 0u}); kx0 = __builtin_bit_cast(bf16x8, (u32x4){k0w, 0u, 0u, 0u}); kx1 = __builtin_bit_cast(bf16x8, (u32x4){k1w, 0u, 0u, 0u}); }
        int n = 0, ch = -1, k = -1, c = (qb > 0) ? (int)CNT[0] : 0; bool have = false;
#define TASK_ADV() do { have = false; for (;;) { ++ch; ++k; while (n < qb && ch >= ((c + 31) >> 5)) { ++n; ch = 0; c = (n < qb) ? (int)CNT[n] : 0; } \
                        if (n >= qb) break; if ((k & 7) == wave) { have = true; break; } } } while (0)
#define TASK_Q(Q2, VALID, QG) do { const int idx_ = ch * 32 + r32; VALID = idx_ < c; Q2 = (int)LIST[n * 256 + (VALID ? idx_ : ch * 32)]; \
                        const bf16* qp_ = qkv + ((size_t)b * SEQ + 256 * qb + Q2) * PA + C_CQ + h * 64 + hi * 8; \
                        _Pragma("unroll") for (int d0 = 0; d0 < 4; ++d0) QG[d0] = *(const bf16x8*)(qp_ + 16 * d0); } while (0)
#define SB_() __builtin_amdgcn_sched_barrier(0)
        TASK_ADV();
        bf16x8 qg[4]; int q2 = 0; bool valid = false; KFr k0, k1; VFr v0; u32x4 pw[4];
        const char* kp = (const char*)KFh + lane * 16; const char* vp = (const char*)VFh + lane * 16;
        if (have) { TASK_Q(q2, valid, qg); kp += (size_t)(4 * n) * 8192; asm volatile("" : "+v"(kp)); loadK(k0, kp); }
        while (have) {
            const int n_c = n; const bool valid_c = valid; const int q2_c = q2;
            vp = (const char*)VFh + (size_t)(4 * n_c) * 8192 + lane * 16; asm volatile("" : "+v"(vp));
            float m2 = -1e30f, l2 = 0.f; f32x16 a0, a1;
#pragma unroll
            for (int r = 0; r < 16; ++r) { a0[r] = 0.f; a1[r] = 0.f; }
            const int kq0 = 256 * n_c - (256 * qb + q2_c);
            TASK_ADV();
            loadV(v0, vp); SB_();
            loadK(k1, kp); SB_(); tile_qk_fast(k0, qg, kx0, kx1, qx, pw, a0, a1, m2, l2, sl2 * (float)(kq0)); SB_();
            tile_pv(v0, pw, a0, a1); SB_();
            loadV(v0, vp); loadK(k0, kp); SB_(); tile_qk_fast(k1, qg, kx0, kx1, qx, pw, a0, a1, m2, l2, sl2 * (float)(kq0 + 64)); SB_();
            tile_pv(v0, pw, a0, a1); SB_();
            loadV(v0, vp); loadK(k1, kp); SB_(); tile_qk_fast(k0, qg, kx0, kx1, qx, pw, a0, a1, m2, l2, sl2 * (float)(kq0 + 128)); SB_();
            tile_pv(v0, pw, a0, a1); SB_();
            bf16x8 qn[4]; int q2n = 0; bool validn = false;
            loadV(v0, vp);
            if (have) { TASK_Q(q2n, validn, qn); kp = (const char*)KFh + (size_t)(4 * n) * 8192 + lane * 16; asm volatile("" : "+v"(kp)); loadK(k0, kp); }
            SB_(); tile_qk_fast(k1, qg, kx0, kx1, qx, pw, a0, a1, m2, l2, sl2 * (float)(kq0 + 192)); SB_();
            tile_pv(v0, pw, a0, a1);
            const float l2t = l2 + __shfl_xor(l2, 32), inv = 1.f / l2t;
            if (valid_c) {
                const unsigned sm = SEL[q2_c]; const int slot = __builtin_popcount(sm & ((1u << n_c) - 1u));
                LAS unsigned char* op = lds + MB_OP + (slot * 256 + q2_c) * MB_OPROW + 8 * hi;
#pragma unroll
                for (int rg = 0; rg < 4; ++rg) {
                    *(LAS u32x2*)(op + 16 * rg) = (u32x2){pk2(a0[4 * rg] * inv, a0[4 * rg + 1] * inv), pk2(a0[4 * rg + 2] * inv, a0[4 * rg + 3] * inv)};
                    *(LAS u32x2*)(op + 64 + 16 * rg) = (u32x2){pk2(a1[4 * rg] * inv, a1[4 * rg + 1] * inv), pk2(a1[4 * rg + 2] * inv, a1[4 * rg + 3] * inv)}; }
                if (hi == 0) *(LAS f32x2v*)(lds + MB_ML + (slot * 256 + q2_c) * 8) = (f32x2v){m2, l2t};
            }
#pragma unroll
            for (int d0 = 0; d0 < 4; ++d0) qg[d0] = qn[d0];
            q2 = q2n; valid = validn;
        }
#undef TASK_ADV
#undef TASK_Q
    }
    int tc_ = threadIdx.x; asm volatile("" : "+v"(tc_));
    const int lane = tc_ & 63, wave = __builtin_amdgcn_readfirstlane(tc_ >> 6), r32 = lane & 31, hi = lane >> 5;
    const int qloc = 32 * wave + r32; const size_t row = (size_t)b * SEQ + 256 * qb + qloc;
    const unsigned selmask = SEL[qloc];
    float m = -1e30f, l = 0.f;
    f32x16 o0, o1;
#pragma unroll
    for (int r = 0; r < 16; ++r) { o0[r] = 0.f; o1[r] = 0.f; }
    {
        const char* kp = (const char*)(KFh + (size_t)(4 * qb) * 4096) + lane * 16; const char* vp = (const char*)(VFh + (size_t)(4 * qb) * 4096) + lane * 16; const int nown = (wave >> 1) + 1;
        asm volatile("" : "+v"(kp)); asm volatile("" : "+v"(vp));
        bf16x8 qo[4];
        { const bf16* qp = qkv + row * PA + C_CQ + h * 64 + hi * 8;
#pragma unroll
          for (int d0 = 0; d0 < 4; ++d0) qo[d0] = *(const bf16x8*)(qp + 16 * d0); }
        KFr k0; VFr v0; u32x4 pw[4];
#pragma unroll 1
        for (int i = 0; i < nown; ++i) {
            loadK(k0, kp); loadV(v0, vp);
            tile_qk<1>(k0, qo, pw, o0, o1, m, l, 64 * i - qloc, sl2, lane); tile_pv(v0, pw, o0, o1);
        }
    }
    WG_BAR();
    {
        const float lt = l + __shfl_xor(l, 32);
        const int nsel = __builtin_popcount(selmask);
        float mj[3], lj[3]; float M = m;
#pragma unroll
        for (int j = 0; j < 3; ++j) { mj[j] = -1e30f; lj[j] = 0.f;
            if (j < nsel) { const f32x2v v = *(LAS const f32x2v*)(lds + MB_ML + (j * 256 + qloc) * 8); mj[j] = v.x; lj[j] = v.y; }
            M = fmaxf(M, mj[j]); }
        const float w0 = __builtin_amdgcn_exp2f(m - M); float den = lt * w0;
#pragma unroll
        for (int r = 0; r < 16; ++r) { o0[r] *= w0; o1[r] *= w0; }
#pragma unroll
        for (int j = 0; j < 3; ++j) {
            if (j < nsel) {
                const float wj = lj[j] * __builtin_amdgcn_exp2f(mj[j] - M); den += wj;
                LAS const unsigned char* op = lds + MB_OP + (j * 256 + qloc) * MB_OPROW + 8 * hi;
#pragma unroll
                for (int rg = 0; rg < 4; ++rg) {
                    const u32x2 x0 = *(LAS const u32x2*)(op + 16 * rg), x1 = *(LAS const u32x2*)(op + 64 + 16 * rg);
                    o0[4 * rg] += wj * bflo(x0.x); o0[4 * rg + 1] += wj * bfhi(x0.x); o0[4 * rg + 2] += wj * bflo(x0.y); o0[4 * rg + 3] += wj * bfhi(x0.y);
                    o1[4 * rg] += wj * bflo(x1.x); o1[4 * rg + 1] += wj * bfhi(x1.x); o1[4 * rg + 2] += wj * bflo(x1.y); o1[4 * rg + 3] += wj * bfhi(x1.y); }
            }
        }
        attn_store(Y + row * 1536 + 1024 + h * 64, o0, o1, 1.f / den, hi);
    }
    WG_BAR();
}

__device__ __forceinline__ void conv_unit(int u, const bf16* qkv, bf16* Y, const float* cw) {
    int tid = threadIdx.x; asm volatile("" : "+v"(tid));
    const int cgp = tid & 63, w = tid >> 6; const int tok0 = 64 * u + 8 * w;
    float w0[8], w1[8], w2[8];
#pragma unroll
    for (int j = 0; j < 8; ++j) { w0[j] = cw[8 * cgp + j]; w1[j] = cw[512 + 8 * cgp + j]; w2[j] = cw[1024 + 8 * cgp + j]; }
    float u2[8], u1[8];
    auto ldu = [&](int rowi, float (&uu)[8]) {
        const bf16* p = qkv + (size_t)rowi * PA + 8 * cgp; const u32x4 hv = *(const u32x4*)(p + C_BH), cv = *(const u32x4*)(p + C_BC);
        uu[0] = bflo(hv.x) * bflo(cv.x); uu[1] = bfhi(hv.x) * bfhi(cv.x); uu[2] = bflo(hv.y) * bflo(cv.y); uu[3] = bfhi(hv.y) * bfhi(cv.y);
        uu[4] = bflo(hv.z) * bflo(cv.z); uu[5] = bfhi(hv.z) * bfhi(cv.z); uu[6] = bflo(hv.w) * bflo(cv.w); uu[7] = bfhi(hv.w) * bfhi(cv.w); };
    if ((tok0 & (SEQ - 1)) == 0) {
#pragma unroll
        for (int j = 0; j < 8; ++j) { u2[j] = 0.f; u1[j] = 0.f; }
    } else { ldu(tok0 - 2, u2); ldu(tok0 - 1, u1); }
#pragma unroll
    for (int t = 0; t < 8; ++t) {
        float uc[8]; ldu(tok0 + t, uc);
        const u32x4 gb = *(const u32x4*)(qkv + (size_t)(tok0 + t) * PA + C_BB + 8 * cgp);
        float y[8];
#pragma unroll
        for (int j = 0; j < 8; ++j) y[j] = w0[j] * u2[j] + w1[j] * u1[j] + w2[j] * uc[j];
        u32x4 o; o.x = pk2(bflo(gb.x) * y[0], bfhi(gb.x) * y[1]); o.y = pk2(bflo(gb.y) * y[2], bfhi(gb.y) * y[3]);
        o.z = pk2(bflo(gb.z) * y[4], bfhi(gb.z) * y[5]); o.w = pk2(bflo(gb.w) * y[6], bfhi(gb.w) * y[7]);
        *(u32x4*)(Y + (size_t)(tok0 + t) * 1536 + 512 + 8 * cgp) = o;
#pragma unroll
        for (int j = 0; j < 8; ++j) { u2[j] = u1[j]; u1[j] = uc[j]; }
    }
}

#define XB_TMO      128
#define XB_XCNT(j)  (256  + 64 * (j))
#define XB_XSUB(j)  (1280 + 64 * (j))
#define XB_XGEN(j)  (2304 + 64 * (j))
#define XB_TOP      3328
#define XB_TOPGEN   3392
#define XCD_BAR_WORDS 3456
#define XB_SPIN_CAP (1u << 18)

__device__ __forceinline__ unsigned xb_ld(unsigned* p)              { return __hip_atomic_load(p, __ATOMIC_RELAXED, __HIP_MEMORY_SCOPE_AGENT); }
__device__ __forceinline__ unsigned xb_add(unsigned* p, unsigned v) { return __hip_atomic_fetch_add(p, v, __ATOMIC_RELAXED, __HIP_MEMORY_SCOPE_AGENT); }
__device__ __forceinline__ unsigned xb_xcc_id() { return (unsigned)__builtin_amdgcn_s_getreg((3 << 11) | 20) & 0xFu; }
#define XB_SPIN(cond, bar) do { unsigned _sp = 0; while (cond) { __builtin_amdgcn_s_sleep(1); \
    if ((++_sp & 255u) == 0u) { if (xb_ld(&(bar)[XB_TMO])) break; if (_sp > XB_SPIN_CAP) { atomicAdd(&(bar)[XB_TMO], 1u); break; } } } } while (0)

struct XcdBarrier {
    unsigned* bar; unsigned x;
    volatile LAS unsigned* st;
};

__device__ __forceinline__ XcdBarrier xcd_barrier_post(unsigned* bar, volatile LAS unsigned* st) {
    XcdBarrier b; b.bar = bar; b.x = xb_xcc_id(); b.st = st;
    if (threadIdx.x == 0) (void)xb_add(&bar[XB_XCNT(b.x)], 1u);
    return b;
}
__device__ __forceinline__ void xcd_barrier_complete(unsigned* bar, unsigned x, unsigned& nloc, unsigned& nx) {
    const unsigned G = gridDim.x * gridDim.y * gridDim.z;
    unsigned sum, cnt, mine, sp = 0u;
    for (;;) {
        sum = 0u; cnt = 0u; mine = 0u;
#pragma unroll
        for (unsigned j = 0; j < 16; ++j) { const unsigned c = xb_ld(&bar[XB_XCNT(j)]); sum += c; cnt += (c > 0u) ? 1u : 0u; mine = (j == x) ? c : mine; }
        if (sum == G) break;
        __builtin_amdgcn_s_sleep(1);
        if ((++sp & 255u) == 0u) { if (xb_ld(&bar[XB_TMO])) break; if (sp > XB_SPIN_CAP) { atomicAdd(&bar[XB_TMO], 1u); break; } }
    }
    nloc = mine > 0u ? mine : 1u; nx = cnt > 0u ? cnt : 1u;
}

__device__ __forceinline__ void xcd_barrier(const XcdBarrier& b) {
    asm volatile("s_waitcnt vmcnt(0)" ::: "memory");
    __syncthreads();
    if (threadIdx.x == 0) {
        unsigned* bar = b.bar;
        __builtin_amdgcn_s_waitcnt(0);
        unsigned nloc = b.st[0], nx = b.st[1];
        if (nloc == 0u) { xcd_barrier_complete(bar, b.x, nloc, nx); b.st[0] = nloc; b.st[1] = nx; }
        const unsigned old = xb_add(&bar[XB_XSUB(b.x)], 1u);
        const unsigned gen = old / nloc;
        if (old + 1u == (gen + 1u) * nloc) {
            __builtin_amdgcn_fence(__ATOMIC_RELEASE, "agent");
            asm volatile("s_waitcnt vmcnt(0)" ::: "memory");
            const unsigned og = xb_add(&bar[XB_TOP], 1u);
            const unsigned tg = og / nx;
            if (og + 1u == (tg + 1u) * nx) xb_add(&bar[XB_TOPGEN], 1u);
            else XB_SPIN(xb_ld(&bar[XB_TOPGEN]) == tg, bar);
            __builtin_amdgcn_fence(__ATOMIC_ACQUIRE, "agent");
            xb_add(&bar[XB_XGEN(b.x)], 1u);
            asm volatile("s_waitcnt vmcnt(0)" ::: "memory");
        } else {
            XB_SPIN(xb_ld(&bar[XB_XGEN(b.x)]) == gen, bar);
            __builtin_amdgcn_fence(__ATOMIC_ACQUIRE, "agent");
            asm volatile("s_waitcnt vmcnt(0)" ::: "memory");
        }
    }
    __syncthreads();
}

struct Args { const float* in[15]; float* out; unsigned char* ws; int ph_lo, ph_hi; };

__global__ void __launch_bounds__(NTHR, 2) fwd_kernel(Args a) {
    extern __shared__ __attribute__((aligned(16))) unsigned char lds_raw[];
    LAS unsigned char* lds = (LAS unsigned char*)lds_raw;
    const int G = gridDim.x, bx = blockIdx.x;
    const int vcu = (G % 8 == 0) ? (bx % 8) * (G / 8) + bx / 8 : bx;
    unsigned char* ws = a.ws;
    bf16* XB = (bf16*)(ws + WS_XB); bf16* QKV = (bf16*)(ws + WS_QKV); bf16* Y = (bf16*)(ws + WS_Y); float* KMEAN = (float*)(ws + WS_KMEAN); bf16* KFb = (bf16*)(ws + WS_KF); bf16* VFb = (bf16*)(ws + WS_VF);
    float* OUT = a.out;
    const int lo = a.ph_lo, hi = a.ph_hi;
    unsigned* barw = (unsigned*)(ws + 65536);
    volatile LAS unsigned* bst = (volatile LAS unsigned*)(lds + 131072);
    if (threadIdx.x < 4) bst[threadIdx.x] = 0u;
    __syncthreads();
    if (lo == 0 && bx == 0) for (int i = threadIdx.x; i < XCD_BAR_WORDS; i += NTHR) barw[i] = 0u;
#define IN(k) (lo <= (k) && (k) < hi)
#define SEAM(k) do { if ((k) + 1 < hi) { if ((k) == 0 || N_LAUNCH != 1) { cg::this_grid().sync(); if (N_LAUNCH == 1 && threadIdx.x == 0) (void)xb_add(&barw[XB_XCNT(xb_xcc_id())], 1u); } \
                                         else { XcdBarrier xb_; xb_.bar = barw; xb_.x = xb_xcc_id(); xb_.st = bst; xcd_barrier(xb_); } } } while (0)

#ifndef S3M
#define S3M 0xff
#endif
#ifndef ONLY
#define ONLY 0xff
#endif
    if ((ONLY & 1) && IN(0)) {
        int t0_ = threadIdx.x; asm volatile("" : "+v"(t0_)); const int lane = t0_ & 63, wave = __builtin_amdgcn_readfirstlane(t0_ >> 6);
        LAS float* scr = (LAS float*)(lds + wave * 16384);
        const int gw = bx * NWAVES + wave, NGW = G * NWAVES;
        constexpr int I_IN = 16 * (PW / 32), I_BR = 8 * 32, I_OUT = 16 * 32, I_G = 16 * (FF / 32), I_DN = (FF / 64) * 32;
        constexpr int I_L = I_IN + 3 * I_BR + I_OUT + 2 * I_G + I_DN;
        for (int it = gw; it < NLAYER * I_L; it += NGW) {
            const int L = it / I_L; int r = it - L * I_L;
            bf16* wb = (bf16*)(ws + WS_W + (size_t)L * LW_SIZE);
            if (r < I_IN) { transpose_item(a.in[1] + (size_t)L * DM * PW, DM, PW, wb + LW_IN / 2, 0, scr, r, lane); continue; } r -= I_IN;
            if (r < 3 * I_BR) { const int br = r / I_BR; transpose_item(a.in[4 + br] + (size_t)L * 512 * DM, 512, DM, wb + LW_BR / 2 + (size_t)br * 1024 * 512, 0, scr, r - br * I_BR, lane); continue; } r -= 3 * I_BR;
            if (r < I_OUT) { transpose_item(a.in[7] + (size_t)L * DM * DM, DM, DM, wb + LW_OUT / 2, 0, scr, r, lane); continue; } r -= I_OUT;
            if (r < I_G) { transpose_item(a.in[10] + (size_t)L * DM * FF, DM, FF, wb + LW_GU / 2, 1, scr, r, lane); continue; } r -= I_G;
            if (r < I_G) { transpose_item(a.in[11] + (size_t)L * DM * FF, DM, FF, wb + LW_GU / 2, 2, scr, r, lane); continue; } r -= I_G;
            transpose_item(a.in[12] + (size_t)L * FF * DM, FF, DM, wb + LW_DN / 2, 0, scr, r, lane);
        }
        for (int pm = bx; pm < NPANEL; pm += G) cvt_panel(pm, a.in[0], XB);
        asm volatile("s_waitcnt vmcnt(0) lgkmcnt(0)" ::: "memory"); WG_BAR();
        SEAM(0);
    }

    for (int L = 0; L < NLAYER; ++L) {
        const bf16* wb = (const bf16*)(ws + WS_W + (size_t)L * LW_SIZE);
        const bf16* W_IN = wb + LW_IN / 2; const bf16* W_BR = wb + LW_BR / 2; const bf16* W_OUT = wb + LW_OUT / 2; const bf16* W_GU = wb + LW_GU / 2; const bf16* W_DN = wb + LW_DN / 2;
        const int P1 = 1 + 3 * L, P2 = 2 + 3 * L, P3 = 3 + 3 * L;
        if ((ONLY & 2) && IN(P1)) {
            for (int pm = bx; pm < NPANEL; pm += G) {
                pg8::Gemm g{XB, W_IN, DM, DM, (size_t)256 * DM * 2}; pg8::PanelSched S{pm, PA / 256};
                LAS float* KS = (LAS float*)(lds + 131072 + 64);
                { int t_ = threadIdx.x; asm volatile("" : "+v"(t_)); KS[t_] = 0.f; }
                WG_BAR();
                pg8::EpiStoreS1 E{QKV, PA, QKV_PSTR, KFb, KS};
                pg8::gemm_phase<pg8::EpiStoreS1, pg8::PanelSched, true, true>(lds, g, S, E);
                asm volatile("s_waitcnt vmcnt(0) lgkmcnt(0)" ::: "memory"); WG_BAR();
                { int t_ = threadIdx.x; asm volatile("" : "+v"(t_));
                  KMEAN[((size_t)((pm >> 5) * 8 + (t_ >> 6)) * 32 + (pm & 31)) * 64 + (t_ & 63)] = KS[t_] * (1.f / 256.f); }
                kvfrag_panel(pm, QKV, KFb, VFb, lds);
                WG_BAR();
            }
            SEAM(P1);
        }
        if ((ONLY & 4) && IN(P2)) {
            if (G == 256) {
                for (int i = 0; i < 8; ++i) { const int bh = (vcu >> 5) * 8 + i, base = ((vcu & 31) + 8 * (i >> 1)) & 31, qb = (i & 1) ? 31 - base : base;
                    moba_unit(bh >> 3, bh & 7, qb, QKV, KFb, VFb, Y, KMEAN, lds); }
            } else {
                for (int u = vcu; u < 2048; u += G) moba_unit(u >> 8, (u >> 5) & 7, u & 31, QKV, KFb, VFb, Y, KMEAN, lds);
            }
            swa_phase(vcu, G, QKV, Y, a.in[2] + L * 8, lds);
            for (int u = bx; u < 1024; u += G) conv_unit(u, QKV, Y, a.in[3] + (size_t)L * 3 * 512);
            SEAM(P2);
        }
        if ((ONLY & 8) && IN(P3)) {
            for (int pm = bx; pm < NPANEL; pm += G) {
                bf16* Gb = QKV + OV_G; bf16* Mg = QKV + OV_MG; bf16* Hb = QKV + OV_H;
                for (int br = 0; br < 3; ++br) {
                    if (S3M & 1) { pg8::Gemm g{XB, W_IN + (size_t)(PA + br * 1024) * DM, DM, DM, (size_t)256 * DM * 2}; pg8::PanelSched S{pm, 4};
                      pg8::EpiStore<1> E{Gb, 1024, QKV_PSTR};
                      pg8::gemm_phase<pg8::EpiStore<1>, pg8::PanelSched, true, true>(lds, g, S, E); }
                    asm volatile("s_waitcnt vmcnt(0)" ::: "memory"); WG_BAR();
                    if (S3M & 2) { pg8::Gemm g{Y + br * 512, W_BR + (size_t)br * 1024 * 512, 512, 1536, (size_t)256 * 1536 * 2}; pg8::PanelSched S{pm, 4};
                      pg8::EpiBranch E{Gb, Mg, QKV_PSTR, br == 0 ? 1 : 0};
                      pg8::gemm_phase<pg8::EpiBranch, pg8::PanelSched, true, true>(lds, g, S, E); }
                    asm volatile("s_waitcnt vmcnt(0)" ::: "memory"); WG_BAR();
                }
                if (S3M & 4) { pg8::Gemm g{Mg, W_OUT, DM, DM, QKV_PSTR * 2}; pg8::PanelSched S{pm, 4};
                  pg8::EpiStore<0> E{QKV + OV_D1, 1024, QKV_PSTR};
                  pg8::gemm_phase<pg8::EpiStore<0>, pg8::PanelSched, true, true>(lds, g, S, E); }
                asm volatile("s_waitcnt vmcnt(0)" ::: "memory"); WG_BAR();
                bf16* LOY = Y + (size_t)pm * 256 * 1536; bf16* LOX = (bf16*)(OUT + (size_t)pm * 256 * DM);
                ln_panel(pm, L == 0 ? a.in[0] : (const float*)nullptr, LOX, QKV + OV_D1 + (size_t)pm * QKV_PSTR, OUT, a.in[8] + L * DM, a.in[9] + L * DM, XB, LOY, false, ALPHA_DN);
                asm volatile("s_waitcnt vmcnt(0)" ::: "memory"); WG_BAR();
                if (S3M & 16) { pg8::Gemm g{XB, W_GU, DM, DM, (size_t)256 * DM * 2}; pg8::PanelSched S{pm, 2 * FF / 256};
                  pg8::EpiSwiglu E{Hb, QKV_PSTR};
                  pg8::gemm_phase<pg8::EpiSwiglu, pg8::PanelSched, true, true>(lds, g, S, E); }
                asm volatile("s_waitcnt vmcnt(0)" ::: "memory"); WG_BAR();
                if (S3M & 32) { pg8::Gemm g{Hb, W_DN, FF, FF, QKV_PSTR * 2}; pg8::PanelSched S{pm, 4};
                  pg8::EpiStore<0> E{QKV + OV_D2, 1024, QKV_PSTR};
                  pg8::gemm_phase<pg8::EpiStore<0>, pg8::PanelSched, true, true>(lds, g, S, E); }
                asm volatile("s_waitcnt vmcnt(0)" ::: "memory"); WG_BAR();
                ln_panel(pm, (const float*)nullptr, LOY, QKV + OV_D2 + (size_t)pm * QKV_PSTR, OUT, a.in[13] + L * DM, a.in[14] + L * DM, XB, LOX, L == NLAYER - 1, ALPHA_DN);
                asm volatile("s_waitcnt vmcnt(0)" ::: "memory"); WG_BAR();
            }
        }
    }
#undef IN
#undef SEAM
}

extern "C" void kernel_launch(void* const* d_in, const int* in_sizes, int n_in, void* d_out, int out_size, void* d_ws, size_t ws_size, hipStream_t stream) {
    static int grid = 0;
    if (grid == 0) {
        if (n_in != 15 || in_sizes[0] != MTOK * DM || out_size != MTOK * DM || ws_size < WS_END) {
            fprintf(stderr, "kernel_launch: unexpected shapes (n_in %d in0 %d out %d ws %zu need %zu)\n", n_in, n_in > 0 ? in_sizes[0] : -1, out_size, ws_size, (size_t)WS_END); grid = -1; return; }
        int dev = 0, cus = 0, per_cu = 0;
        hipGetDevice(&dev); hipDeviceGetAttribute(&cus, hipDeviceAttributeMultiprocessorCount, dev);
        hipFuncSetAttribute((const void*)fwd_kernel, hipFuncAttributeMaxDynamicSharedMemorySize, LDS_BYTES);
        hipOccupancyMaxActiveBlocksPerMultiprocessor(&per_cu, (const void*)fwd_kernel, NTHR, LDS_BYTES);
        (void)hipGetLastError();
        if (per_cu < 1) per_cu = 1;
        grid = cus * per_cu; if (grid > NPANEL) grid = NPANEL; if (grid < 1) grid = 1;
    }
    if (grid < 0) return;
    Args a{};
    for (int i = 0; i < 15; ++i) a.in[i] = (const float*)d_in[i];
    a.out = (float*)d_out; a.ws = (unsigned char*)d_ws;
#if N_LAUNCH == 1
    a.ph_lo = 0; a.ph_hi = 7;
    void* args[] = {&a};
    hipError_t e = hipLaunchCooperativeKernel((const void*)fwd_kernel, dim3(grid), dim3(NTHR), args, LDS_BYTES, stream);
    if (e != hipSuccess) fprintf(stderr, "cooperative launch failed: %s (grid %d)\n", hipGetErrorString(e), grid);
#else
    const int cuts[7] = {0, 1, 2, 3, 5, 6, 7};
    for (int li = 0; li < 6; ++li) { a.ph_lo = cuts[li]; a.ph_hi = cuts[li + 1]; hipLaunchKernelGGL(fwd_kernel, dim3(grid), dim3(NTHR), LDS_BYTES, stream, a); }
#endif
}
```

```cpp
#include <hip/hip_runtime.h>
#include <hip/hip_cooperative_groups.h>
#include <cstdio>
#include <cstdint>
#include <cmath>
namespace cg = cooperative_groups;

#ifndef N_LAUNCH
#define N_LAUNCH 1
#endif

namespace pg8 {
#define PG8_LAS __attribute__((address_space(3)))
typedef unsigned short bf16_t;
typedef short bf16x8 __attribute__((ext_vector_type(8)));
typedef float f32x4 __attribute__((ext_vector_type(4)));
typedef unsigned u32x4 __attribute__((ext_vector_type(4)));
constexpr int BM = 256, BK = 64, HALF = 128, HTB = HALF * BK * 2  , STAGE_BYTES = 8 * HTB;

__host__ __device__ __forceinline__ int lds_byte(int r, int c) { const int st = (r >> 4) * 2 + (c >> 5), rr = r & 15, cc = c & 31, ob = rr * 64 + cc * 2; return st * 1024 + (ob ^ (((ob >> 9) & 1) << 5)); }
__host__ __device__ __forceinline__ void stage_rc(int b, int& R, int& C) { const int st = b / 1024, sb = b % 1024, swz = sb ^ (((sb >> 9) & 1) << 5); R = (st >> 1) * 16 + swz / 64; C = (st & 1) * 32 + (swz % 64) / 2; }
__host__ __device__ __forceinline__ int perm32(int rho) { const int n = rho >> 4, i = rho & 15; return 8 * (i >> 2) + 4 * n + (i & 3); }

struct Unit { int pm, pn; };
struct Gemm { const bf16_t* A; const bf16_t* Bt; int K; int lda; size_t apstride; };

struct PanelSched {
    int pm, nN;
    __device__ __forceinline__ bool next(int i, Unit& u) const { if (i >= nN) return false; u.pm = pm; u.pn = i; return true; }
    __device__ __forceinline__ void a_ready(const Unit&) const {}
    __device__ __forceinline__ void done(const Unit&) const {}
};

typedef float f32x2 __attribute__((ext_vector_type(2)));
typedef __bf16 bf16x2_t __attribute__((ext_vector_type(2)));
__device__ __forceinline__ unsigned cvt_pk_bf16(float lo, float hi) { f32x2 v = {lo, hi}; bf16x2_t b = __builtin_convertvector(v, bf16x2_t); return __builtin_bit_cast(unsigned, b); }
__device__ __forceinline__ float bf_lo(unsigned u) { return __uint_as_float(u << 16); }
__device__ __forceinline__ float bf_hi(unsigned u) { return __uint_as_float(u & 0xffff0000u); }
__device__ __forceinline__ float sigmoidf_(float x) { return __builtin_amdgcn_rcpf(1.0f + __builtin_amdgcn_exp2f(-1.4426950408889634f * x)); }

template <int ACT  > struct EpiStore {
    static constexpr bool PERM = true, AFTER_DRAIN = false;
    bf16_t* O; int ldc; size_t pstride;
    __device__ __forceinline__ void operator()(const f32x4 (&acc)[2][2][4][2], const Unit& u, int wr, int wc, int fr, int fq) const {
        bf16_t* base = O + (size_t)u.pm * pstride + (size_t)(wr * 64 + fr) * ldc + u.pn * BM + wc * 32 + 8 * fq;
#pragma unroll
        for (int ai = 0; ai < 2; ++ai)
#pragma unroll
            for (int m = 0; m < 4; ++m) { bf16_t* rowp = base + (size_t)(ai * HALF + m * 16) * ldc;
#pragma unroll
                for (int bj = 0; bj < 2; ++bj) { f32x4 v0 = acc[ai][bj][m][0], v1 = acc[ai][bj][m][1];
                    if (ACT == 1) { v0 = (f32x4){sigmoidf_(v0[0]), sigmoidf_(v0[1]), sigmoidf_(v0[2]), sigmoidf_(v0[3])}; v1 = (f32x4){sigmoidf_(v1[0]), sigmoidf_(v1[1]), sigmoidf_(v1[2]), sigmoidf_(v1[3])}; }
                    u32x4 w; w.x = cvt_pk_bf16(v0[0], v0[1]); w.y = cvt_pk_bf16(v0[2], v0[3]); w.z = cvt_pk_bf16(v1[0], v1[1]); w.w = cvt_pk_bf16(v1[2], v1[3]);
                    *(u32x4*)(rowp + bj * HALF) = w; } }
    }
};
struct EpiStoreS1 {
    static constexpr bool PERM = true, AFTER_DRAIN = false;
    bf16_t* O; int ldc; size_t pstride; bf16_t* KF; PG8_LAS float* ksum;
    __device__ __forceinline__ void operator()(const f32x4 (&acc)[2][2][4][2], const Unit& u, int wr, int wc, int fr, int fq) const {
        bf16_t* base = O + (size_t)u.pm * pstride + (size_t)(wr * 64 + fr) * ldc + u.pn * BM + wc * 32 + 8 * fq;
        const bool kt = (u.pn == 11 || u.pn == 12);
        const size_t kbase = ((size_t)((u.pm >> 5) * 8 + (u.pn - 11) * 4 + (wc >> 1)) * 128 + (size_t)(u.pm & 31) * 4 + wr) * 4096
                           + (size_t)((2 * (wc & 1) + (fq >> 1)) * 64 + fr + 32 * (fq & 1)) * 8;
#pragma unroll
        for (int ai = 0; ai < 2; ++ai)
#pragma unroll
            for (int m = 0; m < 4; ++m) { bf16_t* rowp = base + (size_t)(ai * HALF + m * 16) * ldc;
#pragma unroll
                for (int bj = 0; bj < 2; ++bj) { const f32x4 v0 = acc[ai][bj][m][0], v1 = acc[ai][bj][m][1];
                    u32x4 w; w.x = cvt_pk_bf16(v0[0], v0[1]); w.y = cvt_pk_bf16(v0[2], v0[3]); w.z = cvt_pk_bf16(v1[0], v1[1]); w.w = cvt_pk_bf16(v1[2], v1[3]);
                    if (!kt) *(u32x4*)(rowp + bj * HALF) = w;
                    else *(u32x4*)(KF + kbase + (size_t)(2 * bj) * 128 * 4096 + (size_t)(2 * ai) * 4096 + (size_t)((m >> 1) * 4 * 64 + 16 * (m & 1)) * 8) = w; } }
        if (kt) {
#pragma unroll
            for (int bj = 0; bj < 2; ++bj) {
                float cs[8];
#pragma unroll
                for (int j = 0; j < 8; ++j) cs[j] = 0.f;
#pragma unroll
                for (int ai = 0; ai < 2; ++ai)
#pragma unroll
                    for (int m = 0; m < 4; ++m)
#pragma unroll
                        for (int j = 0; j < 8; ++j) cs[j] += acc[ai][bj][m][j >> 2][j & 3];
#pragma unroll
                for (int j = 0; j < 8; ++j) { float v = cs[j]; v += __shfl_xor(v, 1); v += __shfl_xor(v, 2); v += __shfl_xor(v, 4); v += __shfl_xor(v, 8); cs[j] = v; }
                if (fr == 0) {
                    PG8_LAS float* kp = ksum + (u.pn - 11) * 256 + bj * HALF + wc * 32 + 8 * fq;
#pragma unroll
                    for (int j = 0; j < 8; ++j) __hip_atomic_fetch_add(kp + j, cs[j], __ATOMIC_RELAXED, __HIP_MEMORY_SCOPE_WORKGROUP);
                }
            }
        }
    }
};
struct EpiBranch {
    static constexpr bool PERM = true, AFTER_DRAIN = false;
    const bf16_t* G; bf16_t* Mg; size_t pstride; int first;
    __device__ __forceinline__ void operator()(const f32x4 (&acc)[2][2][4][2], const Unit& u, int wr, int wc, int fr, int fq) const {
        const size_t off0 = (size_t)u.pm * pstride + (size_t)(wr * 64 + fr) * 1024 + u.pn * BM + wc * 32 + 8 * fq;
#pragma unroll
        for (int ai = 0; ai < 2; ++ai) {
            u32x4 g[4][2], o[4][2];
#pragma unroll
            for (int m = 0; m < 4; ++m)
#pragma unroll
                for (int bj = 0; bj < 2; ++bj) { const size_t off = off0 + (size_t)(ai * HALF + m * 16) * 1024 + bj * HALF;
                    g[m][bj] = *(const u32x4*)(G + off); o[m][bj] = (u32x4){0u, 0u, 0u, 0u}; if (!first) o[m][bj] = *(const u32x4*)(Mg + off); }
#pragma unroll
            for (int m = 0; m < 4; ++m)
#pragma unroll
                for (int bj = 0; bj < 2; ++bj) { const size_t off = off0 + (size_t)(ai * HALF + m * 16) * 1024 + bj * HALF;
                    const f32x4 v0 = acc[ai][bj][m][0], v1 = acc[ai][bj][m][1]; const u32x4 gg = g[m][bj], oo = o[m][bj]; u32x4 w;
                    w.x = cvt_pk_bf16(bf_lo(oo.x) + bf_lo(gg.x) * v0[0], bf_hi(oo.x) + bf_hi(gg.x) * v0[1]);
                    w.y = cvt_pk_bf16(bf_lo(oo.y) + bf_lo(gg.y) * v0[2], bf_hi(oo.y) + bf_hi(gg.y) * v0[3]);
                    w.z = cvt_pk_bf16(bf_lo(oo.z) + bf_lo(gg.z) * v1[0], bf_hi(oo.z) + bf_hi(gg.z) * v1[1]);
                    w.w = cvt_pk_bf16(bf_lo(oo.w) + bf_lo(gg.w) * v1[2], bf_hi(oo.w) + bf_hi(gg.w) * v1[3]);
                    *(u32x4*)(Mg + off) = w; }
            asm volatile("" ::: "memory"); }
    }
};
struct EpiResid {
    static constexpr bool PERM = false, AFTER_DRAIN = false;
    const float* res; float* out; float alpha;
    __device__ __forceinline__ void operator()(const f32x4 (&acc)[2][2][4][2], const Unit& u, int wr, int wc, int fr, int fq) const {
        const size_t off0 = (size_t)(u.pm * BM + wr * 64 + fr) * 1024 + u.pn * BM + wc * 32 + 4 * fq;
#pragma unroll
        for (int ai = 0; ai < 2; ++ai) {
            f32x4 r[4][2][2];
#pragma unroll
            for (int m = 0; m < 4; ++m)
#pragma unroll
                for (int bj = 0; bj < 2; ++bj)
#pragma unroll
                    for (int n = 0; n < 2; ++n) r[m][bj][n] = *(const f32x4*)(res + off0 + (size_t)(ai * HALF + m * 16) * 1024 + bj * HALF + n * 16);
#pragma unroll
            for (int m = 0; m < 4; ++m)
#pragma unroll
                for (int bj = 0; bj < 2; ++bj)
#pragma unroll
                    for (int n = 0; n < 2; ++n) *(f32x4*)(out + off0 + (size_t)(ai * HALF + m * 16) * 1024 + bj * HALF + n * 16) = r[m][bj][n] * alpha + acc[ai][bj][m][n];
            asm volatile("" ::: "memory"); }
    }
};
struct EpiSwiglu {
    static constexpr bool PERM = true, AFTER_DRAIN = false;
    bf16_t* H; size_t pstride;
    __device__ __forceinline__ void operator()(const f32x4 (&acc)[2][2][4][2], const Unit& u, int wr, int wc, int fr, int fq) const {
        bf16_t* base = H + (size_t)u.pm * pstride + (size_t)(wr * 64 + fr) * 2816 + u.pn * HALF + wc * 32 + 8 * fq;
#pragma unroll
        for (int ai = 0; ai < 2; ++ai)
#pragma unroll
            for (int m = 0; m < 4; ++m) { float hv[8];
#pragma unroll
                for (int n = 0; n < 2; ++n)
#pragma unroll
                    for (int i = 0; i < 4; ++i) { const float gt = acc[ai][0][m][n][i], up = acc[ai][1][m][n][i]; hv[n * 4 + i] = gt * sigmoidf_(gt) * up; }
                u32x4 w; w.x = cvt_pk_bf16(hv[0], hv[1]); w.y = cvt_pk_bf16(hv[2], hv[3]); w.z = cvt_pk_bf16(hv[4], hv[5]); w.w = cvt_pk_bf16(hv[6], hv[7]);
                *(u32x4*)(base + (size_t)(ai * HALF + m * 16) * 2816) = w; }
    }
};

template <class Epi, class Sched, bool ALIGN_EPI = false, bool SP2 = false>
__device__ __forceinline__ void gemm_phase(PG8_LAS unsigned char* lds, const Gemm g, const Sched& S, const Epi& E) {
    int tid_ = threadIdx.x; asm volatile("" : "+v"(tid_));
    const int tid = tid_, wid = __builtin_amdgcn_readfirstlane(tid >> 6), lane = tid & 63, wr = wid >> 2, wc = wid & 3, fr = lane & 15, fq = lane >> 4;
    const int K = g.K, nt = K / BK;
    unsigned voffA[2], voffB[2];
#pragma unroll
    for (int i = 0; i < 2; ++i) { int R, C; stage_rc(tid * 16 + i * 8192, R, C); const int Rb = Epi::PERM ? ((R & ~31) + perm32(R & 31)) : R;
        voffA[i] = (unsigned)(R * g.lda + C) * 2u; voffB[i] = (unsigned)(Rb * K + C) * 2u; }
    const size_t kstep = (size_t)(BK * 2);
    const size_t hstepA = (size_t)HALF * g.lda * 2, hstepB = (size_t)HALF * K * 2;
    const size_t tstepA = g.apstride, tstepB = 2 * hstepB;
    const unsigned ldsw = (unsigned)wid * 1024u;
    const int aoff = lds_byte(wr * 64 + fr, fq * 8), boff = lds_byte(wc * 32 + fr, fq * 8);
#define PG8_SA(b, h) (((b) * 2 + (h)) * HTB)
#define PG8_SB(b, h) ((4 + (b) * 2 + (h)) * HTB)
#define PG8_STAGE(bufoff, gbase, voff) do { _Pragma("unroll") for (int _i = 0; _i < 2; ++_i) \
        __builtin_amdgcn_global_load_lds((const unsigned*)((const char*)(gbase) + (voff)[_i]), (PG8_LAS unsigned*)(lds + (bufoff) + ldsw + _i * 8192), 16, 0, 0); } while (0)
#define PG8_LDA(dst, b, h) do { _Pragma("unroll") for (int m = 0; m < 4; ++m) _Pragma("unroll") for (int k = 0; k < 2; ++k) dst[m][k] = *(const PG8_LAS bf16x8*)(lds + PG8_SA(b, h) + aoff + m * 2048 + k * 1024); } while (0)
#define PG8_LDB(dst, b, h) do { _Pragma("unroll") for (int n = 0; n < 2; ++n) _Pragma("unroll") for (int k = 0; k < 2; ++k) dst[n][k] = *(const PG8_LAS bf16x8*)(lds + PG8_SB(b, h) + boff + n * 2048 + k * 1024); } while (0)
#define PG8_MMA(ai, bj, At, Bt) do { __builtin_amdgcn_s_setprio(1); _Pragma("unroll") for (int m = 0; m < 4; ++m) _Pragma("unroll") for (int n = 0; n < 2; ++n) _Pragma("unroll") for (int k = 0; k < 2; ++k) \
        acc[ai][bj][m][n] = __builtin_amdgcn_mfma_f32_16x16x32_bf16(Bt[n][k], At[m][k], acc[ai][bj][m][n], 0, 0, 0); __builtin_amdgcn_s_setprio(0); } while (0)
#define PG8_WAIT_V(n) asm volatile("s_waitcnt vmcnt(" #n ")" ::: "memory")
#define PG8_WAIT_L(n) asm volatile("s_waitcnt lgkmcnt(" #n ")" ::: "memory")
#define PG8_BAR __builtin_amdgcn_s_barrier()
#define PG8_SCHED __builtin_amdgcn_sched_barrier(0)
    Unit cur, nxt; int ui = 0;
    if (!S.next(0, cur)) return;
    f32x4 acc[2][2][4][2];
#pragma unroll
    for (int a = 0; a < 2; ++a)
#pragma unroll
        for (int b = 0; b < 2; ++b)
#pragma unroll
            for (int m = 0; m < 4; ++m)
#pragma unroll
                for (int n = 0; n < 2; ++n) acc[a][b][m][n] = (f32x4){0.f, 0.f, 0.f, 0.f};
    bf16x8 At[4][2], B0[2][2], B1[2][2];
    const char* cA = (const char*)g.A + (size_t)cur.pm * tstepA; const char* cB = (const char*)g.Bt + (size_t)cur.pn * tstepB;
    S.a_ready(cur);
    if constexpr (SP2) {
        PG8_STAGE(PG8_SB(0, 0), cB, voffB); PG8_STAGE(PG8_SB(0, 1), cB + hstepB, voffB); PG8_STAGE(PG8_SA(0, 0), cA, voffA); PG8_STAGE(PG8_SA(0, 1), cA + hstepA, voffA);
        if (wr == 1) PG8_BAR;
        PG8_WAIT_V(2); PG8_BAR;
        PG8_STAGE(PG8_SB(1, 0), cB + kstep, voffB); PG8_STAGE(PG8_SA(1, 0), cA + kstep, voffA); PG8_STAGE(PG8_SB(1, 1), cB + hstepB + kstep, voffB);
        PG8_WAIT_V(6); PG8_BAR;
    } else {
        PG8_STAGE(PG8_SB(0, 0), cB, voffB); PG8_STAGE(PG8_SA(0, 0), cA, voffA); PG8_STAGE(PG8_SB(0, 1), cB + hstepB, voffB); PG8_STAGE(PG8_SA(0, 1), cA + hstepA, voffA);
        if (wr == 1) PG8_BAR;
        PG8_WAIT_V(4); PG8_BAR;
        PG8_STAGE(PG8_SB(1, 0), cB + kstep, voffB); PG8_STAGE(PG8_SA(1, 0), cA + kstep, voffA); PG8_STAGE(PG8_SB(1, 1), cB + hstepB + kstep, voffB);
        PG8_WAIT_V(6); PG8_BAR;
    }
    for (;;) {
        const bool has_next = S.next(ui + 1, nxt);
        const char* nA = has_next ? (const char*)g.A + (size_t)nxt.pm * tstepA : cA; const char* nB = has_next ? (const char*)g.Bt + (size_t)nxt.pn * tstepB : cB;
        for (int t = 0; t < nt; t += 2) {
            const bool last = (t == nt - 2);
            const char* a1 = cA + (size_t)(t + 1) * kstep;
            const char* a2 = last ? nA : cA + (size_t)(t + 2) * kstep; const char* b2 = last ? nB : cB + (size_t)(t + 2) * kstep;
            const char* a3 = a2 + kstep; const char* b3 = b2 + kstep;
            if (last && has_next) S.a_ready(nxt);
            if constexpr (SP2) {
            PG8_LDB(B0, 0, 0); PG8_LDB(B1, 0, 1); PG8_SCHED; PG8_LDA(At, 0, 0); PG8_STAGE(PG8_SA(1, 1), a1 + hstepA, voffA);
            PG8_WAIT_V(8); PG8_WAIT_L(0); PG8_BAR; PG8_MMA(0, 0, At, B0); PG8_MMA(0, 1, At, B1); PG8_BAR; PG8_SCHED;
            PG8_LDA(At, 0, 1); PG8_STAGE(PG8_SB(0, 0), b2, voffB); PG8_STAGE(PG8_SB(0, 1), b2 + hstepB, voffB); PG8_STAGE(PG8_SA(0, 0), a2, voffA);
            PG8_WAIT_V(8); PG8_WAIT_L(0); PG8_BAR; PG8_MMA(1, 0, At, B0); PG8_MMA(1, 1, At, B1); PG8_BAR; PG8_SCHED;
            PG8_LDB(B0, 1, 0); PG8_LDB(B1, 1, 1); PG8_SCHED; PG8_LDA(At, 1, 0); PG8_STAGE(PG8_SA(0, 1), a2 + hstepA, voffA);
            PG8_WAIT_V(8); PG8_WAIT_L(0); PG8_BAR; PG8_MMA(0, 0, At, B0); PG8_MMA(0, 1, At, B1); PG8_BAR; PG8_SCHED;
            PG8_LDA(At, 1, 1); PG8_STAGE(PG8_SB(1, 0), b3, voffB); PG8_STAGE(PG8_SB(1, 1), b3 + hstepB, voffB); PG8_STAGE(PG8_SA(1, 0), a3, voffA);
            PG8_WAIT_V(8); PG8_WAIT_L(0); PG8_BAR; PG8_MMA(1, 0, At, B0); PG8_MMA(1, 1, At, B1); PG8_BAR; PG8_SCHED;
            } else {
            PG8_LDB(B0, 0, 0); PG8_SCHED; PG8_LDA(At, 0, 0); PG8_STAGE(PG8_SA(1, 1), a1 + hstepA, voffA);
            PG8_WAIT_L(8); PG8_BAR; PG8_WAIT_L(0); PG8_MMA(0, 0, At, B0); PG8_BAR; PG8_SCHED;
            PG8_LDB(B1, 0, 1); PG8_STAGE(PG8_SB(0, 0), b2, voffB);
            PG8_BAR; PG8_WAIT_L(0); PG8_MMA(0, 1, At, B1); PG8_BAR;
            PG8_LDA(At, 0, 1); PG8_STAGE(PG8_SA(0, 0), a2, voffA);
            PG8_BAR; PG8_WAIT_L(0); PG8_MMA(1, 0, At, B0); PG8_BAR; PG8_SCHED;
            PG8_STAGE(PG8_SB(0, 1), b2 + hstepB, voffB);
            PG8_WAIT_V(6); PG8_BAR; PG8_MMA(1, 1, At, B1); PG8_BAR;
            PG8_LDB(B0, 1, 0); PG8_SCHED; PG8_LDA(At, 1, 0); PG8_STAGE(PG8_SA(0, 1), a2 + hstepA, voffA);
            PG8_WAIT_L(8); PG8_BAR; PG8_WAIT_L(0); PG8_MMA(0, 0, At, B0); PG8_BAR; PG8_SCHED;
            PG8_LDB(B1, 1, 1); PG8_STAGE(PG8_SB(1, 0), b3, voffB);
            PG8_BAR; PG8_WAIT_L(0); PG8_MMA(0, 1, At, B1); PG8_BAR;
            PG8_LDA(At, 1, 1); PG8_STAGE(PG8_SA(1, 0), a3, voffA);
            PG8_BAR; PG8_WAIT_L(0); PG8_MMA(1, 0, At, B0); PG8_BAR; PG8_SCHED;
            PG8_STAGE(PG8_SB(1, 1), b3 + hstepB, voffB);
            PG8_WAIT_V(6); PG8_BAR; PG8_MMA(1, 1, At, B1); PG8_BAR;
            }
        }
        if constexpr (ALIGN_EPI) { if (wr == 0) PG8_BAR; }
        if constexpr (!Epi::AFTER_DRAIN) { E(acc, cur, wr, wc, fr, fq); S.done(cur); }
        if (!has_next) break;
#pragma unroll
        for (int a = 0; a < 2; ++a)
#pragma unroll
            for (int b = 0; b < 2; ++b)
#pragma unroll
                for (int m = 0; m < 4; ++m)
#pragma unroll
                    for (int n = 0; n < 2; ++n) acc[a][b][m][n] = (f32x4){0.f, 0.f, 0.f, 0.f};
        cur = nxt; cA = nA; cB = nB; ++ui;
        if constexpr (ALIGN_EPI) { if (wr == 1) PG8_BAR; }
    }
    PG8_WAIT_V(0);
    if constexpr (!ALIGN_EPI) { if (wr == 0) PG8_BAR; }
    PG8_BAR;
    if constexpr (Epi::AFTER_DRAIN) { E.fused(acc, cur, wr, wc, fr, fq, lds, wid, lane); S.done(cur); }
#undef PG8_SA
#undef PG8_SB
#undef PG8_STAGE
#undef PG8_LDA
#undef PG8_LDB
#undef PG8_MMA
#undef PG8_WAIT_V
#undef PG8_WAIT_L
#undef PG8_BAR
#undef PG8_SCHED
}
}

#define LAS __attribute__((address_space(3)))
typedef unsigned short bf16;
typedef short bf16x8 __attribute__((ext_vector_type(8)));
typedef short s16x4 __attribute__((ext_vector_type(4)));
typedef float f32x4 __attribute__((ext_vector_type(4)));
typedef float f32x16 __attribute__((ext_vector_type(16)));
typedef unsigned u32x4 __attribute__((ext_vector_type(4)));
typedef unsigned u32x2 __attribute__((ext_vector_type(2)));
typedef float f32x2v __attribute__((ext_vector_type(2)));

constexpr int BATCH = 8, SEQ = 8192, DM = 1024, MTOK = BATCH * SEQ, NPANEL = MTOK / 256, PW = 6912, PA = 3840, FF = 2816, NLAYER = 2;
constexpr float LOG2E = 1.4426950408889634f, LN_EPS = 1e-5f, ALPHA_DN = 1.4142135623730951f;
constexpr int C_AQ = 0, C_AK = 512, C_AV = 640, C_BH = 768, C_BB = 1280, C_BC = 1792, C_CQ = 2304, C_CK = 2816, C_CV = 3328;
constexpr size_t MiB = 1u << 20;
constexpr size_t LW_IN = 0, LW_BR = 14 * MiB, LW_OUT = 17 * MiB, LW_GU = 19 * MiB, LW_DN = 30 * MiB, LW_SIZE = 36 * MiB;
constexpr size_t WS_W = 1 * MiB, WS_XB = WS_W + 2 * LW_SIZE, WS_QKV = WS_XB + 128 * MiB, WS_Y = WS_QKV + 480 * MiB, WS_KMEAN = WS_Y + 192 * MiB, WS_KF = WS_KMEAN + 1 * MiB, WS_VF = WS_KF + 64 * MiB, WS_END = WS_VF + 64 * MiB;
constexpr size_t QKV_PSTR = (size_t)256 * PA;
constexpr size_t OV_G = 0, OV_MG = 256 * 1024, OV_H = 0, OV_D1 = 0  , OV_D2 = 256 * 2816  ;
constexpr int NWAVES = 8, NTHR = 512;
constexpr int LDS_BYTES = 131072 + 4096;
constexpr int MB_OP = 0, MB_OPROW = 136, MB_ML = 3 * 256 * MB_OPROW, MB_LIST = MB_ML + 3 * 256 * 8, MB_CNT = MB_LIST + 32 * 256, MB_SEL = MB_CNT + 128, MB_END = MB_SEL + 1024;
static_assert(MB_END <= 131072, "moba lds");
constexpr int AL_K0 = 0, AL_KSZ = 64 * 144, AL_V0 = 2 * AL_KSZ, AL_VSZ = 64 * 136, AL_KM = AL_V0 + 2 * AL_VSZ, AL_END = AL_KM + 8192;

__device__ __forceinline__ unsigned pk2(float lo, float hi) { return pg8::cvt_pk_bf16(lo, hi); }
__device__ __forceinline__ float bflo(unsigned u) { return __uint_as_float(u << 16); }
__device__ __forceinline__ float bfhi(unsigned u) { return __uint_as_float(u & 0xffff0000u); }
__device__ __forceinline__ float wave_sum(float v) {
#pragma unroll
    for (int o = 1; o < 64; o <<= 1) v += __shfl_xor(v, o);
    return v;
}
#define WG_BAR() __syncthreads()

__device__ __forceinline__ void transpose_item(const float* W, int K, int N, bf16* WT, int mode, LAS float* scr, int item, int lane) {
    const int nblk = N / 32, kb = item / nblk, nb = item % nblk, k0 = 64 * kb, n0 = 32 * nb;
    int r0 = n0;
    if (mode == 1) r0 = 256 * (n0 >> 7) + (n0 & 127);
    else if (mode == 2) r0 = 256 * (n0 >> 7) + 128 + (n0 & 127);
#pragma unroll 8
    for (int i = 0; i < 32; ++i) { const int kk = 2 * i + (lane >> 5); scr[kk * 33 + (lane & 31)] = W[(size_t)(k0 + kk) * N + n0 + (lane & 31)]; }
    asm volatile("s_waitcnt lgkmcnt(0)" ::: "memory");
    const int c = lane & 7;
#pragma unroll
    for (int j = 0; j < 4; ++j) { const int n = (lane >> 3) + 8 * j; const LAS float* s = scr + (8 * c) * 33 + n;
        u32x4 o; o.x = pk2(s[0 * 33], s[1 * 33]); o.y = pk2(s[2 * 33], s[3 * 33]); o.z = pk2(s[4 * 33], s[5 * 33]); o.w = pk2(s[6 * 33], s[7 * 33]);
        *(u32x4*)(WT + (size_t)(r0 + n) * K + k0 + 8 * c) = o; }
    asm volatile("s_waitcnt lgkmcnt(0)" ::: "memory");
}

__device__ __forceinline__ void ln_panel(int pm, const float* resf, const bf16* rlo, const bf16* dlt, float* xo, const float* gam, const float* bet, bf16* xb, bf16* wlo, bool fin, float alpha) {
    int tid = threadIdx.x; asm volatile("" : "+v"(tid)); const int lane = tid & 63, wave = __builtin_amdgcn_readfirstlane(tid >> 6);
    f32x4 gv[4], bv[4];
#pragma unroll
    for (int j = 0; j < 4; ++j) { gv[j] = *(const f32x4*)(gam + 4 * lane + 256 * j); bv[j] = *(const f32x4*)(bet + 4 * lane + 256 * j); }
#pragma unroll 4
    for (int r = wave * 32; r < wave * 32 + 32; ++r) {
        const size_t grow = (size_t)(pm * 256 + r) * DM + 4 * lane, prow = (size_t)r * DM + 4 * lane;
        f32x4 v[4]; float s = 0.f;
#pragma unroll
        for (int j = 0; j < 4; ++j) { f32x4 x; const u32x2 d = *(const u32x2*)(dlt + prow + 256 * j);
            if (resf) x = *(const f32x4*)(resf + grow + 256 * j);
            else { const u32x2 h = *(const u32x2*)(xb + grow + 256 * j), l = *(const u32x2*)(rlo + prow + 256 * j);
                   x = (f32x4){bflo(h.x) + bflo(l.x), bfhi(h.x) + bfhi(l.x), bflo(h.y) + bflo(l.y), bfhi(h.y) + bfhi(l.y)}; }
            v[j] = (f32x4){x.x * alpha + bflo(d.x), x.y * alpha + bfhi(d.x), x.z * alpha + bflo(d.y), x.w * alpha + bfhi(d.y)}; s += (v[j].x + v[j].y) + (v[j].z + v[j].w); }
        const float mean = wave_sum(s) * (1.f / DM); float s2 = 0.f;
#pragma unroll
        for (int j = 0; j < 4; ++j) { v[j] = v[j] - mean; s2 += (v[j].x * v[j].x + v[j].y * v[j].y) + (v[j].z * v[j].z + v[j].w * v[j].w); }
        const float rstd = 1.f / sqrtf(wave_sum(s2) * (1.f / DM) + LN_EPS);
#pragma unroll
        for (int j = 0; j < 4; ++j) { const f32x4 o = v[j] * rstd * gv[j] + bv[j];
            if (fin) *(f32x4*)(xo + grow + 256 * j) = o;
            else { u32x2 w; w.x = pk2(o.x, o.y); w.y = pk2(o.z, o.w); *(u32x2*)(xb + grow + 256 * j) = w;
                   u32x2 q; q.x = pk2(o.x - bflo(w.x), o.y - bfhi(w.x)); q.y = pk2(o.z - bflo(w.y), o.w - bfhi(w.y)); *(u32x2*)(wlo + prow + 256 * j) = q; } }
    }
}
__device__ __forceinline__ void cvt_panel(int pm, const float* x, bf16* xb) {
    int tid = threadIdx.x; asm volatile("" : "+v"(tid));
    const float* src = x + (size_t)pm * 256 * DM; bf16* dst = xb + (size_t)pm * 256 * DM;
#pragma unroll 4
    for (int i = tid; i < 256 * DM / 8; i += NTHR) { const f32x4 a = *(const f32x4*)(src + (size_t)i * 8), b = *(const f32x4*)(src + (size_t)i * 8 + 4);
        u32x4 w; w.x = pk2(a.x, a.y); w.y = pk2(a.z, a.w); w.z = pk2(b.x, b.y); w.w = pk2(b.z, b.w); *(u32x4*)(dst + (size_t)i * 8) = w; }
}
__device__ __forceinline__ void kmean_panel(int pm, const bf16* qkv, float* kmean, LAS float* scr) {
    int tid = threadIdx.x; asm volatile("" : "+v"(tid));
    const int cg8 = tid & 63, rg = tid >> 6; float s[8];
#pragma unroll
    for (int j = 0; j < 8; ++j) s[j] = 0.f;
    const bf16* p = qkv + (size_t)(pm * 256 + rg * 32) * PA + C_CK + 8 * cg8;
#pragma unroll 8
    for (int r = 0; r < 32; ++r) { const u32x4 v = *(const u32x4*)(p + (size_t)r * PA);
        s[0] += bflo(v.x); s[1] += bfhi(v.x); s[2] += bflo(v.y); s[3] += bfhi(v.y); s[4] += bflo(v.z); s[5] += bfhi(v.z); s[6] += bflo(v.w); s[7] += bfhi(v.w); }
#pragma unroll
    for (int j = 0; j < 8; ++j) scr[rg * 512 + 8 * cg8 + j] = s[j];
    WG_BAR();
    float t = 0.f;
#pragma unroll
    for (int g = 0; g < 8; ++g) t += scr[g * 512 + tid];
    const int b = pm >> 5, n = pm & 31, h = tid >> 6, d = tid & 63;
    kmean[((size_t)(b * 8 + h) * 32 + n) * 64 + d] = t * (1.f / 256.f);
    WG_BAR();
}

__device__ __forceinline__ void kvfrag_panel(int pm, const bf16* qkv, bf16* KF, bf16* VF, LAS unsigned char* lds) {
    int tid = threadIdx.x; asm volatile("" : "+v"(tid));
    const int lane = tid & 63, h = __builtin_amdgcn_readfirstlane(tid >> 6), r32 = lane & 31, hi = lane >> 5;
    const int b = pm >> 5, n = pm & 31;
    LAS unsigned short* vt = (LAS unsigned short*)(lds + h * 8704);
    u32x4 vr[2][8];
#define VF_LOAD(t, s) do { const bf16* vrow_ = qkv + (size_t)(pm * 256 + 64 * (t) + lane) * PA + C_CV + 64 * h; \
        _Pragma("unroll") for (int c = 0; c < 8; ++c) vr[s][c] = *(const u32x4*)(vrow_ + 8 * c); } while (0)
    VF_LOAD(0, 0);
#pragma unroll
    for (int t = 0; t < 4; ++t) {
        const int s = t & 1;
        if (t + 1 < 4) VF_LOAD(t + 1, s ^ 1);
        const size_t tile = ((size_t)(b * 8 + h) * 128 + n * 4 + t) * 4096;
#pragma unroll
        for (int c = 0; c < 8; ++c) { const u32x4 v = vr[s][c];
            LAS unsigned short* p = vt + (8 * c) * 68 + lane;
            p[0 * 68] = (unsigned short)(v.x & 0xffffu); p[1 * 68] = (unsigned short)(v.x >> 16); p[2 * 68] = (unsigned short)(v.y & 0xffffu); p[3 * 68] = (unsigned short)(v.y >> 16);
            p[4 * 68] = (unsigned short)(v.z & 0xffffu); p[5 * 68] = (unsigned short)(v.z >> 16); p[6 * 68] = (unsigned short)(v.w & 0xffffu); p[7 * 68] = (unsigned short)(v.w >> 16); }
        asm volatile("s_waitcnt lgkmcnt(0)" ::: "memory");
#pragma unroll
        for (int dh = 0; dh < 2; ++dh)
#pragma unroll
            for (int ks = 0; ks < 4; ++ks) {
                LAS const unsigned char* vp = (LAS const unsigned char*)vt + (32 * dh + r32) * 136 + hi * 8 + (32 * (ks >> 1) + 16 * (ks & 1)) * 2;
                const u32x2 lo = *(LAS const u32x2*)vp, hh = *(LAS const u32x2*)(vp + 16);
                *(u32x4*)(VF + tile + ((dh * 4 + ks) * 64 + lane) * 8) = (u32x4){lo.x, lo.y, hh.x, hh.y}; }
        asm volatile("s_waitcnt lgkmcnt(0)" ::: "memory");
    }
#undef VF_LOAD
}

struct Stage { u32x4 k, v; };
__device__ __forceinline__ void stage_ld(Stage& s, const bf16* Kg, const bf16* Vg, int key0, int tid) {
    const size_t o = (size_t)(key0 + (tid >> 3)) * PA + (tid & 7) * 8; s.k = *(const u32x4*)(Kg + o); s.v = *(const u32x4*)(Vg + o);
}
__device__ __forceinline__ void stage_st(const Stage& s, LAS unsigned char* Kb, LAS unsigned char* Vb, int tid) {
    const int key = tid >> 3, ch = tid & 7;
    *(LAS u32x4*)(Kb + key * 144 + ch * 16) = s.k;
    LAS unsigned short* vt = (LAS unsigned short*)Vb + (ch * 8) * 68 + key;
    vt[0 * 68] = (unsigned short)(s.v.x & 0xffffu); vt[1 * 68] = (unsigned short)(s.v.x >> 16);
    vt[2 * 68] = (unsigned short)(s.v.y & 0xffffu); vt[3 * 68] = (unsigned short)(s.v.y >> 16);
    vt[4 * 68] = (unsigned short)(s.v.z & 0xffffu); vt[5 * 68] = (unsigned short)(s.v.z >> 16);
    vt[6 * 68] = (unsigned short)(s.v.w & 0xffffu); vt[7 * 68] = (unsigned short)(s.v.w >> 16);
}
template <int MASK>
__device__ __forceinline__ void attn_tile(LAS const unsigned char* Kb, LAS const unsigned char* Vb, const bf16x8 (&qf)[4], f32x16& o0, f32x16& o1, float& m, float& l,
                                          int kq, float sl2, bool lane_ok, int r32, int hi) {
    f32x16 p0, p1;
#pragma unroll
    for (int r = 0; r < 16; ++r) { p0[r] = 0.f; p1[r] = 0.f; }
    LAS const unsigned char* kp = Kb + r32 * 144 + hi * 16;
#pragma unroll
    for (int d0 = 0; d0 < 4; ++d0) {
        const bf16x8 a0 = *(LAS const bf16x8*)(kp + d0 * 32), a1 = *(LAS const bf16x8*)(kp + 32 * 144 + d0 * 32);
        p0 = __builtin_amdgcn_mfma_f32_32x32x16_bf16(a0, qf[d0], p0, 0, 0, 0);
        p1 = __builtin_amdgcn_mfma_f32_32x32x16_bf16(a1, qf[d0], p1, 0, 0, 0);
    }
    constexpr float C2 = 0.125f * LOG2E;
    const int dk0 = kq + 4 * hi;
    const float base = sl2 * (float)dk0;
    const float NEG = -INFINITY;
    float mx = NEG;
#pragma unroll
    for (int r = 0; r < 16; ++r) {
        const int kk = (r & 3) + 8 * (r >> 2);
        float t0 = fmaf(p0[r], C2, fmaf((float)kk, sl2, base)), t1 = fmaf(p1[r], C2, fmaf((float)(kk + 32), sl2, base));
        if (MASK == 1) { if (dk0 + kk > 0) t0 = NEG; if (dk0 + kk + 32 > 0) t1 = NEG; }
        if (MASK == 2) { const int a = dk0 + kk, b = a + 32; if (a > 0 || a <= -128) t0 = NEG; if (b > 0 || b <= -128) t1 = NEG; }
        if (MASK == 0) { if (!lane_ok) { t0 = NEG; t1 = NEG; } }
        p0[r] = t0; p1[r] = t1; mx = fmaxf(mx, fmaxf(t0, t1));
    }
    mx = fmaxf(mx, __shfl_xor(mx, 32));
    const float mn = fmaxf(m, mx), alpha = __builtin_amdgcn_exp2f(m - mn); m = mn;
    float rs = 0.f;
#pragma unroll
    for (int r = 0; r < 16; ++r) { p0[r] = __builtin_amdgcn_exp2f(p0[r] - mn); p1[r] = __builtin_amdgcn_exp2f(p1[r] - mn); rs += p0[r] + p1[r]; }
    l = l * alpha + rs;
#pragma unroll
    for (int r = 0; r < 16; ++r) { o0[r] *= alpha; o1[r] *= alpha; }
    u32x4 pw[4];
    pw[0] = (u32x4){pk2(p0[0], p0[1]), pk2(p0[2], p0[3]), pk2(p0[4], p0[5]), pk2(p0[6], p0[7])};
    pw[1] = (u32x4){pk2(p0[8], p0[9]), pk2(p0[10], p0[11]), pk2(p0[12], p0[13]), pk2(p0[14], p0[15])};
    pw[2] = (u32x4){pk2(p1[0], p1[1]), pk2(p1[2], p1[3]), pk2(p1[4], p1[5]), pk2(p1[6], p1[7])};
    pw[3] = (u32x4){pk2(p1[8], p1[9]), pk2(p1[10], p1[11]), pk2(p1[12], p1[13]), pk2(p1[14], p1[15])};
    LAS const unsigned char* vp = Vb + r32 * 136 + hi * 8;
#pragma unroll
    for (int ks = 0; ks < 4; ++ks) {
        const int koff = (32 * (ks >> 1) + 16 * (ks & 1)) * 2;
        const s16x4 a0l = *(LAS const s16x4*)(vp + koff), a0h = *(LAS const s16x4*)(vp + koff + 16);
        const s16x4 a1l = *(LAS const s16x4*)(vp + 32 * 136 + koff), a1h = *(LAS const s16x4*)(vp + 32 * 136 + koff + 16);
        const bf16x8 A0 = (bf16x8){a0l[0], a0l[1], a0l[2], a0l[3], a0h[0], a0h[1], a0h[2], a0h[3]};
        const bf16x8 A1 = (bf16x8){a1l[0], a1l[1], a1l[2], a1l[3], a1h[0], a1h[1], a1h[2], a1h[3]};
        const bf16x8 P = __builtin_bit_cast(bf16x8, pw[ks]);
        o0 = __builtin_amdgcn_mfma_f32_32x32x16_bf16(A0, P, o0, 0, 0, 0);
        o1 = __builtin_amdgcn_mfma_f32_32x32x16_bf16(A1, P, o1, 0, 0, 0);
    }
}
__device__ __forceinline__ void attn_store(bf16* yrow, const f32x16& o0, const f32x16& o1, float inv, int hi) {
#pragma unroll
    for (int rg = 0; rg < 4; ++rg) {
        u32x2 w0, w1;
        w0.x = pk2(o0[4 * rg] * inv, o0[4 * rg + 1] * inv); w0.y = pk2(o0[4 * rg + 2] * inv, o0[4 * rg + 3] * inv);
        w1.x = pk2(o1[4 * rg] * inv, o1[4 * rg + 1] * inv); w1.y = pk2(o1[4 * rg + 2] * inv, o1[4 * rg + 3] * inv);
        *(u32x2*)(yrow + 8 * rg + 4 * hi) = w0; *(u32x2*)(yrow + 32 + 8 * rg + 4 * hi) = w1;
    }
}

template <int MASK>
__device__ __forceinline__ void attn_tile_fast(LAS const unsigned char* Kb, LAS const unsigned char* Vb, const bf16x8 (&qf)[4], const bf16x8& kx0, const bf16x8& kx1, const bf16x8& qx,
                                               f32x16& o0, f32x16& o1, float& m, float& l, int kq, float off, int r32, int hi) {
    f32x16 p0, p1;
#pragma unroll
    for (int r = 0; r < 16; ++r) { p0[r] = 0.f; p1[r] = 0.f; }
    p0 = __builtin_amdgcn_mfma_f32_32x32x16_bf16(kx0, qx, p0, 0, 0, 0);
    p1 = __builtin_amdgcn_mfma_f32_32x32x16_bf16(kx1, qx, p1, 0, 0, 0);
    LAS const unsigned char* kp = Kb + r32 * 144 + hi * 16;
#pragma unroll
    for (int d0 = 0; d0 < 4; ++d0) {
        const bf16x8 a0 = *(LAS const bf16x8*)(kp + d0 * 32), a1 = *(LAS const bf16x8*)(kp + 32 * 144 + d0 * 32);
        p0 = __builtin_amdgcn_mfma_f32_32x32x16_bf16(a0, qf[d0], p0, 0, 0, 0);
        p1 = __builtin_amdgcn_mfma_f32_32x32x16_bf16(a1, qf[d0], p1, 0, 0, 0);
    }
    constexpr float C2 = 0.125f * LOG2E;
    const float NEG = -INFINITY;
    if (MASK != 0) {
        const int dk0 = kq + 4 * hi;
#pragma unroll
        for (int r = 0; r < 16; ++r) { const int kk = (r & 3) + 8 * (r >> 2);
            if (MASK == 1) { if (dk0 > -kk) p0[r] = NEG; if (dk0 > -(kk + 32)) p1[r] = NEG; }
            if (MASK == 3) { if (dk0 <= -128 - kk) p0[r] = NEG; if (dk0 <= -160 - kk) p1[r] = NEG; } }
    }
    float mr = fmaxf(p0[0], p1[0]);
#pragma unroll
    for (int r = 1; r < 16; ++r) mr = fmaxf(fmaxf(mr, p0[r]), p1[r]);
    float mx = fmaf(mr, C2, off);
    mx = fmaxf(mx, __shfl_xor(mx, 32));
    const float mn = fmaxf(m, mx);
    if (__ballot(mn > m) != 0ull) {
        const float alpha = __builtin_amdgcn_exp2f(m - mn); l *= alpha;
#pragma unroll
        for (int r = 0; r < 16; ++r) { o0[r] *= alpha; o1[r] *= alpha; }
    }
    m = mn;
    const float sh = off - mn;
    float rs = 0.f;
#pragma unroll
    for (int r = 0; r < 16; ++r) { p0[r] = __builtin_amdgcn_exp2f(fmaf(p0[r], C2, sh)); p1[r] = __builtin_amdgcn_exp2f(fmaf(p1[r], C2, sh)); rs += p0[r] + p1[r]; }
    l += rs;
    u32x4 pw[4];
    pw[0] = (u32x4){pk2(p0[0], p0[1]), pk2(p0[2], p0[3]), pk2(p0[4], p0[5]), pk2(p0[6], p0[7])};
    pw[1] = (u32x4){pk2(p0[8], p0[9]), pk2(p0[10], p0[11]), pk2(p0[12], p0[13]), pk2(p0[14], p0[15])};
    pw[2] = (u32x4){pk2(p1[0], p1[1]), pk2(p1[2], p1[3]), pk2(p1[4], p1[5]), pk2(p1[6], p1[7])};
    pw[3] = (u32x4){pk2(p1[8], p1[9]), pk2(p1[10], p1[11]), pk2(p1[12], p1[13]), pk2(p1[14], p1[15])};
    LAS const unsigned char* vp = Vb + r32 * 136 + hi * 8;
#pragma unroll
    for (int ks = 0; ks < 4; ++ks) {
        const int koff = (32 * (ks >> 1) + 16 * (ks & 1)) * 2;
        const s16x4 a0l = *(LAS const s16x4*)(vp + koff), a0h = *(LAS const s16x4*)(vp + koff + 16);
        const s16x4 a1l = *(LAS const s16x4*)(vp + 32 * 136 + koff), a1h = *(LAS const s16x4*)(vp + 32 * 136 + koff + 16);
        const bf16x8 A0 = (bf16x8){a0l[0], a0l[1], a0l[2], a0l[3], a0h[0], a0h[1], a0h[2], a0h[3]};
        const bf16x8 A1 = (bf16x8){a1l[0], a1l[1], a1l[2], a1l[3], a1h[0], a1h[1], a1h[2], a1h[3]};
        const bf16x8 P = __builtin_bit_cast(bf16x8, pw[ks]);
        o0 = __builtin_amdgcn_mfma_f32_32x32x16_bf16(A0, P, o0, 0, 0, 0);
        o1 = __builtin_amdgcn_mfma_f32_32x32x16_bf16(A1, P, o1, 0, 0, 0);
    }
}
__device__ __forceinline__ void swa_phase(int first, int stride, const bf16* qkv, bf16* Y, const float* sinks, LAS unsigned char* lds) {
    int tid = threadIdx.x; asm volatile("" : "+v"(tid));
    const int lane = tid & 63, wave = tid >> 6, r32 = lane & 31, hi = lane >> 5;
    constexpr int SV0 = 3 * AL_KSZ;
    Stage st[3];
    int u = first;
    if (u < 2048) { const int tb = u & 127, kvh = (u >> 7) & 1, b = u >> 8; const int nt = (tb + 1 < 3) ? tb + 1 : 3;
        const bf16* Kg = qkv + (size_t)b * SEQ * PA + C_AK + kvh * 64; const bf16* Vg = qkv + (size_t)b * SEQ * PA + C_AV + kvh * 64;
#pragma unroll
        for (int i = 0; i < 3; ++i) if (i < nt) stage_ld(st[i], Kg, Vg, 64 * (tb - i), tid); }
    for (; u < 2048; u += stride) {
        const int tb = u & 127, kvh = (u >> 7) & 1, b = u >> 8; const int nt = (tb + 1 < 3) ? tb + 1 : 3;
        const int head = 4 * kvh + (wave >> 1), qtok = 64 * tb + 32 * (wave & 1) + r32;
        const size_t row = (size_t)b * SEQ + qtok;
#pragma unroll
        for (int i = 0; i < 3; ++i) if (i < nt) stage_st(st[i], lds + i * AL_KSZ, lds + SV0 + i * AL_VSZ, tid);
        bf16x8 qf[4];
        { const bf16* qp = qkv + row * PA + C_AQ + head * 64 + hi * 8;
#pragma unroll
          for (int d0 = 0; d0 < 4; ++d0) qf[d0] = *(const bf16x8*)(qp + 16 * d0); }
        WG_BAR();
        { const int un = u + stride;
          if (un < 2048) { const int tb2 = un & 127, kvh2 = (un >> 7) & 1, b2 = un >> 8; const int nt2 = (tb2 + 1 < 3) ? tb2 + 1 : 3;
            const bf16* Kg = qkv + (size_t)b2 * SEQ * PA + C_AK + kvh2 * 64; const bf16* Vg = qkv + (size_t)b2 * SEQ * PA + C_AV + kvh2 * 64;
#pragma unroll
            for (int i = 0; i < 3; ++i) if (i < nt2) stage_ld(st[i], Kg, Vg, 64 * (tb2 - i), tid); } }
        const float sl2 = exp2f(-0.5f * (float)(head + 1)) * LOG2E;
        float m = sinks[head] * LOG2E, l = (hi == 0) ? 1.f : 0.f;
        f32x16 o0, o1;
#pragma unroll
        for (int r = 0; r < 16; ++r) { o0[r] = 0.f; o1[r] = 0.f; }
        bf16x8 kx0, kx1, qx;
        { const float xs = sl2 * (1.f / (0.125f * LOG2E)); const unsigned shb = pk2(xs, 0.f) & 0xffffu; const float res = xs - __uint_as_float(shb << 16);
          const unsigned qw = (hi == 0) ? (shb | (pk2(res, 0.f) << 16)) : 0u;
          const unsigned k0w = (hi == 0) ? pk2((float)r32, (float)r32) : 0u, k1w = (hi == 0) ? pk2((float)(r32 + 32), (float)(r32 + 32)) : 0u;
          qx = __builtin_bit_cast(bf16x8, (u32x4){qw, 0u, 0u, 0u}); kx0 = __builtin_bit_cast(bf16x8, (u32x4){k0w, 0u, 0u, 0u}); kx1 = __builtin_bit_cast(bf16x8, (u32x4){k1w, 0u, 0u, 0u}); }
        { const int kq = 64 * tb - qtok; attn_tile_fast<1>(lds, lds + SV0, qf, kx0, kx1, qx, o0, o1, m, l, kq, sl2 * (float)kq, r32, hi); }
        if (nt > 1) { const int kq = 64 * (tb - 1) - qtok; attn_tile_fast<0>(lds + AL_KSZ, lds + SV0 + AL_VSZ, qf, kx0, kx1, qx, o0, o1, m, l, kq, sl2 * (float)kq, r32, hi); }
        if (nt > 2) { const int kq = 64 * (tb - 2) - qtok; attn_tile_fast<3>(lds + 2 * AL_KSZ, lds + SV0 + 2 * AL_VSZ, qf, kx0, kx1, qx, o0, o1, m, l, kq, sl2 * (float)kq, r32, hi); }
        const float lt = l + __shfl_xor(l, 32);
        attn_store(Y + row * 1536 + head * 64, o0, o1, 1.f / lt, hi);
        WG_BAR();
    }
}

struct KFr { bf16x8 a[2][4]; };
struct VFr { bf16x8 a[2][4]; };
__device__ __forceinline__ void loadK(KFr& f, const char*& p) {
#pragma unroll
    for (int kh = 0; kh < 2; ++kh) {
#pragma unroll
        for (int d0 = 0; d0 < 4; ++d0) f.a[kh][d0] = *(const bf16x8*)(p + d0 * 1024);
        p += 4096; asm volatile("" : "+v"(p));
    }
}
__device__ __forceinline__ void loadV(VFr& f, const char*& p) {
#pragma unroll
    for (int dh = 0; dh < 2; ++dh) {
#pragma unroll
        for (int ks = 0; ks < 4; ++ks) f.a[dh][ks] = *(const bf16x8*)(p + ks * 1024);
        p += 4096; asm volatile("" : "+v"(p));
    }
}
template <int MASK>
__device__ __forceinline__ void tile_qk(const KFr& f, const bf16x8 (&qf)[4], u32x4 (&pw)[4], f32x16& o0, f32x16& o1, float& m, float& l, int kq, float sl2, int lane) {
    const int hi = lane >> 5;
    f32x16 p0, p1;
#pragma unroll
    for (int r = 0; r < 16; ++r) { p0[r] = 0.f; p1[r] = 0.f; }
#pragma unroll
    for (int d0 = 0; d0 < 4; ++d0) {
        p0 = __builtin_amdgcn_mfma_f32_32x32x16_bf16(f.a[0][d0], qf[d0], p0, 0, 0, 0);
        p1 = __builtin_amdgcn_mfma_f32_32x32x16_bf16(f.a[1][d0], qf[d0], p1, 0, 0, 0);
    }
    constexpr float C2 = 0.125f * LOG2E;
    const int dk0 = kq + 4 * hi;
    float sl = sl2; asm volatile("" : "+v"(sl));
    const float base = sl * (float)dk0;
    const float NEG = -INFINITY;
    float mx = NEG;
#pragma unroll
    for (int r = 0; r < 16; ++r) {
        const int kk = (r & 3) + 8 * (r >> 2);
        float t0 = fmaf(p0[r], C2, fmaf((float)kk, sl, base)), t1 = fmaf(p1[r], C2, fmaf((float)(kk + 32), sl, base));
        if (MASK == 1) { if (dk0 + kk > 0) t0 = NEG; if (dk0 + kk + 32 > 0) t1 = NEG; }
        p0[r] = t0; p1[r] = t1; mx = fmaxf(mx, fmaxf(t0, t1));
    }
    mx = fmaxf(mx, __shfl_xor(mx, 32));
    const float mn = fmaxf(m, mx), alpha = __builtin_amdgcn_exp2f(m - mn); m = mn;
    float rs = 0.f;
#pragma unroll
    for (int r = 0; r < 16; ++r) { p0[r] = __builtin_amdgcn_exp2f(p0[r] - mn); p1[r] = __builtin_amdgcn_exp2f(p1[r] - mn); rs += p0[r] + p1[r]; }
    l = l * alpha + rs;
#pragma unroll
    for (int r = 0; r < 16; ++r) { o0[r] *= alpha; o1[r] *= alpha; }
    pw[0] = (u32x4){pk2(p0[0], p0[1]), pk2(p0[2], p0[3]), pk2(p0[4], p0[5]), pk2(p0[6], p0[7])};
    pw[1] = (u32x4){pk2(p0[8], p0[9]), pk2(p0[10], p0[11]), pk2(p0[12], p0[13]), pk2(p0[14], p0[15])};
    pw[2] = (u32x4){pk2(p1[0], p1[1]), pk2(p1[2], p1[3]), pk2(p1[4], p1[5]), pk2(p1[6], p1[7])};
    pw[3] = (u32x4){pk2(p1[8], p1[9]), pk2(p1[10], p1[11]), pk2(p1[12], p1[13]), pk2(p1[14], p1[15])};
}
__device__ __forceinline__ void tile_qk_fast(const KFr& f, const bf16x8 (&qf)[4], const bf16x8& kx0, const bf16x8& kx1, const bf16x8& qx, u32x4 (&pw)[4],
                                             f32x16& o0, f32x16& o1, float& m, float& l, float off) {
    f32x16 p0, p1;
#pragma unroll
    for (int r = 0; r < 16; ++r) { p0[r] = 0.f; p1[r] = 0.f; }
    p0 = __builtin_amdgcn_mfma_f32_32x32x16_bf16(kx0, qx, p0, 0, 0, 0);
    p1 = __builtin_amdgcn_mfma_f32_32x32x16_bf16(kx1, qx, p1, 0, 0, 0);
#pragma unroll
    for (int d0 = 0; d0 < 4; ++d0) {
        p0 = __builtin_amdgcn_mfma_f32_32x32x16_bf16(f.a[0][d0], qf[d0], p0, 0, 0, 0);
        p1 = __builtin_amdgcn_mfma_f32_32x32x16_bf16(f.a[1][d0], qf[d0], p1, 0, 0, 0);
    }
    constexpr float C2 = 0.125f * LOG2E;
    float mr = fmaxf(p0[0], p1[0]);
#pragma unroll
    for (int r = 1; r < 16; ++r) mr = fmaxf(fmaxf(mr, p0[r]), p1[r]);
    float mx = fmaf(mr, C2, off);
    mx = fmaxf(mx, __shfl_xor(mx, 32));
    const float mn = fmaxf(m, mx);
    if (__ballot(mn > m) != 0ull) {
        const float alpha = __builtin_amdgcn_exp2f(m - mn); l *= alpha;
#pragma unroll
        for (int r = 0; r < 16; ++r) { o0[r] *= alpha; o1[r] *= alpha; }
    }
    m = mn;
    const float sh = off - mn;
    float rs = 0.f;
#pragma unroll
    for (int r = 0; r < 16; ++r) { p0[r] = __builtin_amdgcn_exp2f(fmaf(p0[r], C2, sh)); p1[r] = __builtin_amdgcn_exp2f(fmaf(p1[r], C2, sh)); rs += p0[r] + p1[r]; }
    l += rs;
    pw[0] = (u32x4){pk2(p0[0], p0[1]), pk2(p0[2], p0[3]), pk2(p0[4], p0[5]), pk2(p0[6], p0[7])};
    pw[1] = (u32x4){pk2(p0[8], p0[9]), pk2(p0[10], p0[11]), pk2(p0[12], p0[13]), pk2(p0[14], p0[15])};
    pw[2] = (u32x4){pk2(p1[0], p1[1]), pk2(p1[2], p1[3]), pk2(p1[4], p1[5]), pk2(p1[6], p1[7])};
    pw[3] = (u32x4){pk2(p1[8], p1[9]), pk2(p1[10], p1[11]), pk2(p1[12], p1[13]), pk2(p1[14], p1[15])};
}
__device__ __forceinline__ void tile_pv(const VFr& f, const u32x4 (&pw)[4], f32x16& o0, f32x16& o1) {
#pragma unroll
    for (int ks = 0; ks < 4; ++ks) {
        const bf16x8 P = __builtin_bit_cast(bf16x8, pw[ks]);
        o0 = __builtin_amdgcn_mfma_f32_32x32x16_bf16(f.a[0][ks], P, o0, 0, 0, 0);
        o1 = __builtin_amdgcn_mfma_f32_32x32x16_bf16(f.a[1][ks], P, o1, 0, 0, 0);
    }
}

__device__ __forceinline__ void moba_unit(int b, int h, int qb, const bf16* qkv, const bf16* KF, const bf16* VF, bf16* Y, const float* kmean, LAS unsigned char* lds) {
    const bf16* KFh = KF + (size_t)(b * 8 + h) * 128 * 4096; const bf16* VFh = VF + (size_t)(b * 8 + h) * 128 * 4096;
    LAS unsigned* CNT = (LAS unsigned*)(lds + MB_CNT); LAS unsigned char* LIST = lds + MB_LIST; LAS unsigned* SEL = (LAS unsigned*)(lds + MB_SEL);
    {
    int tid = threadIdx.x; asm volatile("" : "+v"(tid));
    const int lane = tid & 63, wave = __builtin_amdgcn_readfirstlane(tid >> 6), r32 = lane & 31, hi = lane >> 5;
    const int qloc = 32 * wave + r32, qtok = 256 * qb + qloc;
    const size_t row = (size_t)b * SEQ + qtok;
    bf16x8 qf[4];
    { const bf16* qp = qkv + row * PA + C_CQ + h * 64 + hi * 8;
#pragma unroll
      for (int d0 = 0; d0 < 4; ++d0) qf[d0] = *(const bf16x8*)(qp + 16 * d0); }
    LAS float* KM = (LAS float*)(lds + MB_OP);
    { const f32x4* src = (const f32x4*)(kmean + (size_t)(b * 8 + h) * 32 * 64); for (int i = tid; i < qb * 16; i += NTHR) *(LAS f32x4*)(KM + 4 * i) = src[i]; }
    if (tid < 32) CNT[tid] = 0u;
    WG_BAR();
    unsigned selmask = 0u;
    {
        float v1 = -INFINITY, v2 = -INFINITY, v3 = -INFINITY; int i1 = 0, i2 = 0, i3 = 0;
        for (int n = 0; n < qb; ++n) {
            float part = 0.f;
#pragma unroll
            for (int d0 = 0; d0 < 4; ++d0) {
                const f32x4 ka = *(LAS const f32x4*)(KM + n * 64 + 16 * d0 + 8 * hi), kb = *(LAS const f32x4*)(KM + n * 64 + 16 * d0 + 8 * hi + 4);
                const u32x4 q = __builtin_bit_cast(u32x4, qf[d0]);
                part += bflo(q.x) * ka.x + bfhi(q.x) * ka.y + bflo(q.y) * ka.z + bfhi(q.y) * ka.w + bflo(q.z) * kb.x + bfhi(q.z) * kb.y + bflo(q.w) * kb.z + bfhi(q.w) * kb.w;
            }
            const float g = part + __shfl_xor(part, 32);
            if (g > v1) { v3 = v2; i3 = i2; v2 = v1; i2 = i1; v1 = g; i1 = n; }
            else if (g > v2) { v3 = v2; i3 = i2; v2 = g; i2 = n; }
            else if (g > v3) { v3 = g; i3 = n; }
        }
        if (v1 > -INFINITY) selmask |= 1u << i1;
        if (v2 > -INFINITY) selmask |= 1u << i2;
        if (v3 > -INFINITY) selmask |= 1u << i3;
    }
    WG_BAR();
    if (hi == 0) {
        SEL[qloc] = selmask;
        unsigned mm = selmask;
        while (mm) { const int n = __builtin_ctz(mm); mm &= mm - 1u;
            const unsigned pos = __hip_atomic_fetch_add(CNT + n, 1u, __ATOMIC_RELAXED, __HIP_MEMORY_SCOPE_WORKGROUP);
            LIST[n * 256 + pos] = (unsigned char)qloc; }
    }
    WG_BAR();
    }
    const float sl2 = exp2f(-0.5f * (float)(h + 9)) * LOG2E;
    {
        int tb_ = threadIdx.x; asm volatile("" : "+v"(tb_));
        const int lane = tb_ & 63, wave = __builtin_amdgcn_readfirstlane(tb_ >> 6), r32 = lane & 31, hi = lane >> 5;
        bf16x8 kx0, kx1, qx;
        { const float xs = sl2 * (1.f / (0.125f * LOG2E)); const unsigned shb = pk2(xs, 0.f) & 0xffffu; const float res = xs - __uint_as_float(shb << 16);
          const unsigned qw = (hi == 0) ? (shb | (pk2(res, 0.f) << 16)) : 0u;
          const unsigned k0w = (hi == 0) ? pk2((float)r32, (float)r32) : 0u, k1w = (hi == 0) ? pk2((float)(r32 + 32), (float)(r32 + 32)) : 0u;
          qx = __builtin_bit_cast(bf16x8, (u32x4){qw, 0u, 0u, 0u}); kx0 = __builtin_bit_cast(bf16x8, (u32x4){k0w, 0u, 0u, 0u}); kx1 = __builtin_bit_cast(bf16x8, (u32x4){k1w, 0u, 0u, 0u}); }
        int n = 0, ch = -1, k = -1, c = (qb > 0) ? (int)CNT[0] : 0; bool have = false;
#define TASK_ADV() do { have = false; for (;;) { ++ch; ++k; while (n < qb && ch >= ((c + 31) >> 5)) { ++n; ch = 0; c = (n < qb) ? (int)CNT[n] : 0; } \
                        if (n >= qb) break; if ((k & 7) == wave) { have = true; break; } } } while (0)
#define TASK_Q(Q2, VALID, QG) do { const int idx_ = ch * 32 + r32; VALID = idx_ < c; Q2 = (int)LIST[n * 256 + (VALID ? idx_ : ch * 32)]; \
                        const bf16* qp_ = qkv + ((size_t)b * SEQ + 256 * qb + Q2) * PA + C_CQ + h * 64 + hi * 8; \
                        _Pragma("unroll") for (int d0 = 0; d0 < 4; ++d0) QG[d0] = *(const bf16x8*)(qp_ + 16 * d0); } while (0)
#define SB_() __builtin_amdgcn_sched_barrier(0)
        TASK_ADV();
        bf16x8 qg[4]; int q2 = 0; bool valid = false; KFr k0, k1; VFr v0; u32x4 pw[4];
        const char* kp = (const char*)KFh + lane * 16; const char* vp = (const char*)VFh + lane * 16;
        if (have) { TASK_Q(q2, valid, qg); kp += (size_t)(4 * n) * 8192; asm volatile("" : "+v"(kp)); loadK(k0, kp); }
        while (have) {
            const int n_c = n; const bool valid_c = valid; const int q2_c = q2;
            vp = (const char*)VFh + (size_t)(4 * n_c) * 8192 + lane * 16; asm volatile("" : "+v"(vp));
            float m2 = -1e30f, l2 = 0.f; f32x16 a0, a1;
#pragma unroll
            for (int r = 0; r < 16; ++r) { a0[r] = 0.f; a1[r] = 0.f; }
            const int kq0 = 256 * n_c - (256 * qb + q2_c);
            TASK_ADV();
            loadV(v0, vp); SB_();
            loadK(k1, kp); SB_(); tile_qk_fast(k0, qg, kx0, kx1, qx, pw, a0, a1, m2, l2, sl2 * (float)(kq0)); SB_();
            tile_pv(v0, pw, a0, a1); SB_();
            loadV(v0, vp); loadK(k0, kp); SB_(); tile_qk_fast(k1, qg, kx0, kx1, qx, pw, a0, a1, m2, l2, sl2 * (float)(kq0 + 64)); SB_();
            tile_pv(v0, pw, a0, a1); SB_();
            loadV(v0, vp); loadK(k1, kp); SB_(); tile_qk_fast(k0, qg, kx0, kx1, qx, pw, a0, a1, m2, l2, sl2 * (float)(kq0 + 128)); SB_();
            tile_pv(v0, pw, a0, a1); SB_();
            bf16x8 qn[4]; int q2n = 0; bool validn = false;
            loadV(v0, vp);
            if (have) { TASK_Q(q2n, validn, qn); kp = (const char*)KFh + (size_t)(4 * n) * 8192 + lane * 16; asm volatile("" : "+v"(kp)); loadK(k0, kp); }
            SB_(); tile_qk_fast(k1, qg, kx0, kx1, qx, pw, a0, a1, m2, l2, sl2 * (float)(kq0 + 192)); SB_();
            tile_pv(v0, pw, a0, a1);
            const float l2t = l2 + __shfl_xor(l2, 32), inv = 1.f / l2t;
            if (valid_c) {
                const unsigned sm = SEL[q2_c]; const int slot = __builtin_popcount(sm & ((1u << n_c) - 1u));
                LAS unsigned char* op = lds + MB_OP + (slot * 256 + q2_c) * MB_OPROW + 8 * hi;
#pragma unroll
                for (int rg = 0; rg < 4; ++rg) {
                    *(LAS u32x2*)(op + 16 * rg) = (u32x2){pk2(a0[4 * rg] * inv, a0[4 * rg + 1] * inv), pk2(a0[4 * rg + 2] * inv, a0[4 * rg + 3] * inv)};
                    *(LAS u32x2*)(op + 64 + 16 * rg) = (u32x2){pk2(a1[4 * rg] * inv, a1[4 * rg + 1] * inv), pk2(a1[4 * rg + 2] * inv, a1[4 * rg + 3] * inv)}; }
                if (hi == 0) *(LAS f32x2v*)(lds + MB_ML + (slot * 256 + q2_c) * 8) = (f32x2v){m2, l2t};
            }
#pragma unroll
            for (int d0 = 0; d0 < 4; ++d0) qg[d0] = qn[d0];
            q2 = q2n; valid = validn;
        }
#undef TASK_ADV
#undef TASK_Q
    }
    int tc_ = threadIdx.x; asm volatile("" : "+v"(tc_));
    const int lane = tc_ & 63, wave = __builtin_amdgcn_readfirstlane(tc_ >> 6), r32 = lane & 31, hi = lane >> 5;
    const int qloc = 32 * wave + r32; const size_t row = (size_t)b * SEQ + 256 * qb + qloc;
    const unsigned selmask = SEL[qloc];
    float m = -1e30f, l = 0.f;
    f32x16 o0, o1;
#pragma unroll
    for (int r = 0; r < 16; ++r) { o0[r] = 0.f; o1[r] = 0.f; }
    {
        const char* kp = (const char*)(KFh + (size_t)(4 * qb) * 4096) + lane * 16; const char* vp = (const char*)(VFh + (size_t)(4 * qb) * 4096) + lane * 16; const int nown = (wave >> 1) + 1;
        asm volatile("" : "+v"(kp)); asm volatile("" : "+v"(vp));
        bf16x8 qo[4];
        { const bf16* qp = qkv + row * PA + C_CQ + h * 64 + hi * 8;
#pragma unroll
          for (int d0 = 0; d0 < 4; ++d0) qo[d0] = *(const bf16x8*)(qp + 16 * d0); }
        KFr k0; VFr v0; u32x4 pw[4];
#pragma unroll 1
        for (int i = 0; i < nown; ++i) {
            loadK(k0, kp); loadV(v0, vp);
            tile_qk<1>(k0, qo, pw, o0, o1, m, l, 64 * i - qloc, sl2, lane); tile_pv(v0, pw, o0, o1);
        }
    }
    WG_BAR();
    {
        const float lt = l + __shfl_xor(l, 32);
        const int nsel = __builtin_popcount(selmask);
        float mj[3], lj[3]; float M = m;
#pragma unroll
        for (int j = 0; j < 3; ++j) { mj[j] = -1e30f; lj[j] = 0.f;
            if (j < nsel) { const f32x2v v = *(LAS const f32x2v*)(lds + MB_ML + (j * 256 + qloc) * 8); mj[j] = v.x; lj[j] = v.y; }
            M = fmaxf(M, mj[j]); }
        const float w0 = __builtin_amdgcn_exp2f(m - M); float den = lt * w0;
#pragma unroll
        for (int r = 0; r < 16; ++r) { o0[r] *= w0; o1[r] *= w0; }
#pragma unroll
        for (int j = 0; j < 3; ++j) {
            if (j < nsel) {
                const float wj = lj[j] * __builtin_amdgcn_exp2f(mj[j] - M); den += wj;
                LAS const unsigned char* op = lds + MB_OP + (j * 256 + qloc) * MB_OPROW + 8 * hi;
#pragma unroll
                for (int rg = 0; rg < 4; ++rg) {
                    const u32x2 x0 = *(LAS const u32x2*)(op + 16 * rg), x1 = *(LAS const u32x2*)(op + 64 + 16 * rg);
                    o0[4 * rg] += wj * bflo(x0.x); o0[4 * rg + 1] += wj * bfhi(x0.x); o0[4 * rg + 2] += wj * bflo(x0.y); o0[4 * rg + 3] += wj * bfhi(x0.y);
                    o1[4 * rg] += wj * bflo(x1.x); o1[4 * rg + 1] += wj * bfhi(x1.x); o1[4 * rg + 2] += wj * bflo(x1.y); o1[4 * rg + 3] += wj * bfhi(x1.y); }
            }
        }
        attn_store(Y + row * 1536 + 1024 + h * 64, o0, o1, 1.f / den, hi);
    }
    WG_BAR();
}

__device__ __forceinline__ void conv_unit(int u, const bf16* qkv, bf16* Y, const float* cw) {
    int tid = threadIdx.x; asm volatile("" : "+v"(tid));
    const int cgp = tid & 63, w = tid >> 6; const int tok0 = 64 * u + 8 * w;
    float w0[8], w1[8], w2[8];
#pragma unroll
    for (int j = 0; j < 8; ++j) { w0[j] = cw[8 * cgp + j]; w1[j] = cw[512 + 8 * cgp + j]; w2[j] = cw[1024 + 8 * cgp + j]; }
    float u2[8], u1[8];
    auto ldu = [&](int rowi, float (&uu)[8]) {
        const bf16* p = qkv + (size_t)rowi * PA + 8 * cgp; const u32x4 hv = *(const u32x4*)(p + C_BH), cv = *(const u32x4*)(p + C_BC);
        uu[0] = bflo(hv.x) * bflo(cv.x); uu[1] = bfhi(hv.x) * bfhi(cv.x); uu[2] = bflo(hv.y) * bflo(cv.y); uu[3] = bfhi(hv.y) * bfhi(cv.y);
        uu[4] = bflo(hv.z) * bflo(cv.z); uu[5] = bfhi(hv.z) * bfhi(cv.z); uu[6] = bflo(hv.w) * bflo(cv.w); uu[7] = bfhi(hv.w) * bfhi(cv.w); };
    if ((tok0 & (SEQ - 1)) == 0) {
#pragma unroll
        for (int j = 0; j < 8; ++j) { u2[j] = 0.f; u1[j] = 0.f; }
    } else { ldu(tok0 - 2, u2); ldu(tok0 - 1, u1); }
#pragma unroll
    for (int t = 0; t < 8; ++t) {
        float uc[8]; ldu(tok0 + t, uc);
        const u32x4 gb = *(const u32x4*)(qkv + (size_t)(tok0 + t) * PA + C_BB + 8 * cgp);
        float y[8];
#pragma unroll
        for (int j = 0; j < 8; ++j) y[j] = w0[j] * u2[j] + w1[j] * u1[j] + w2[j] * uc[j];
        u32x4 o; o.x = pk2(bflo(gb.x) * y[0], bfhi(gb.x) * y[1]); o.y = pk2(bflo(gb.y) * y[2], bfhi(gb.y) * y[3]);
        o.z = pk2(bflo(gb.z) * y[4], bfhi(gb.z) * y[5]); o.w = pk2(bflo(gb.w) * y[6], bfhi(gb.w) * y[7]);
        *(u32x4*)(Y + (size_t)(tok0 + t) * 1536 + 512 + 8 * cgp) = o;
#pragma unroll
        for (int j = 0; j < 8; ++j) { u2[j] = u1[j]; u1[j] = uc[j]; }
    }
}

#define XB_TMO      128
#define XB_XCNT(j)  (256  + 64 * (j))
#define XB_XSUB(j)  (1280 + 64 * (j))
#define XB_XGEN(j)  (2304 + 64 * (j))
#define XB_TOP      3328
#define XB_TOPGEN   3392
#define XCD_BAR_WORDS 3456
#define XB_SPIN_CAP (1u << 18)

__device__ __forceinline__ unsigned xb_ld(unsigned* p)              { return __hip_atomic_load(p, __ATOMIC_RELAXED, __HIP_MEMORY_SCOPE_AGENT); }
__device__ __forceinline__ unsigned xb_add(unsigned* p, unsigned v) { return __hip_atomic_fetch_add(p, v, __ATOMIC_RELAXED, __HIP_MEMORY_SCOPE_AGENT); }
__device__ __forceinline__ unsigned xb_xcc_id() { return (unsigned)__builtin_amdgcn_s_getreg((3 << 11) | 20) & 0xFu; }
#define XB_SPIN(cond, bar) do { unsigned _sp = 0; while (cond) { __builtin_amdgcn_s_sleep(1); \
    if ((++_sp & 255u) == 0u) { if (xb_ld(&(bar)[XB_TMO])) break; if (_sp > XB_SPIN_CAP) { atomicAdd(&(bar)[XB_TMO], 1u); break; } } } } while (0)

struct XcdBarrier {
    unsigned* bar; unsigned x;
    volatile LAS unsigned* st;
};

__device__ __forceinline__ XcdBarrier xcd_barrier_post(unsigned* bar, volatile LAS unsigned* st) {
    XcdBarrier b; b.bar = bar; b.x = xb_xcc_id(); b.st = st;
    if (threadIdx.x == 0) (void)xb_add(&bar[XB_XCNT(b.x)], 1u);
    return b;
}
__device__ __forceinline__ void xcd_barrier_complete(unsigned* bar, unsigned x, unsigned& nloc, unsigned& nx) {
    const unsigned G = gridDim.x * gridDim.y * gridDim.z;
    unsigned sum, cnt, mine, sp = 0u;
    for (;;) {
        sum = 0u; cnt = 0u; mine = 0u;
#pragma unroll
        for (unsigned j = 0; j < 16; ++j) { const unsigned c = xb_ld(&bar[XB_XCNT(j)]); sum += c; cnt += (c > 0u) ? 1u : 0u; mine = (j == x) ? c : mine; }
        if (sum == G) break;
        __builtin_amdgcn_s_sleep(1);
        if ((++sp & 255u) == 0u) { if (xb_ld(&bar[XB_TMO])) break; if (sp > XB_SPIN_CAP) { atomicAdd(&bar[XB_TMO], 1u); break; } }
    }
    nloc = mine > 0u ? mine : 1u; nx = cnt > 0u ? cnt : 1u;
}

__device__ __forceinline__ void xcd_barrier(const XcdBarrier& b) {
    asm volatile("s_waitcnt vmcnt(0)" ::: "memory");
    __syncthreads();
    if (threadIdx.x == 0) {
        unsigned* bar = b.bar;
        __builtin_amdgcn_s_waitcnt(0);
        unsigned nloc = b.st[0], nx = b.st[1];
        if (nloc == 0u) { xcd_barrier_complete(bar, b.x, nloc, nx); b.st[0] = nloc; b.st[1] = nx; }
        const unsigned old = xb_add(&bar[XB_XSUB(b.x)], 1u);
        const unsigned gen = old / nloc;
        if (old + 1u == (gen + 1u) * nloc) {
            __builtin_amdgcn_fence(__ATOMIC_RELEASE, "agent");
            asm volatile("s_waitcnt vmcnt(0)" ::: "memory");
            const unsigned og = xb_add(&bar[XB_TOP], 1u);
            const unsigned tg = og / nx;
            if (og + 1u == (tg + 1u) * nx) xb_add(&bar[XB_TOPGEN], 1u);
            else XB_SPIN(xb_ld(&bar[XB_TOPGEN]) == tg, bar);
            __builtin_amdgcn_fence(__ATOMIC_ACQUIRE, "agent");
            xb_add(&bar[XB_XGEN(b.x)], 1u);
            asm volatile("s_waitcnt vmcnt(0)" ::: "memory");
        } else {
            XB_SPIN(xb_ld(&bar[XB_XGEN(b.x)]) == gen, bar);
            __builtin_amdgcn_fence(__ATOMIC_ACQUIRE, "agent");
            asm volatile("s_waitcnt vmcnt(0)" ::: "memory");
        }
    }
    __syncthreads();
}

struct Args { const float* in[15]; float* out; unsigned char* ws; int ph_lo, ph_hi; };

__global__ void __launch_bounds__(NTHR, 2) fwd_kernel(Args a) {
    extern __shared__ __attribute__((aligned(16))) unsigned char lds_raw[];
    LAS unsigned char* lds = (LAS unsigned char*)lds_raw;
    const int G = gridDim.x, bx = blockIdx.x;
    const int vcu = (G % 8 == 0) ? (bx % 8) * (G / 8) + bx / 8 : bx;
    unsigned char* ws = a.ws;
    bf16* XB = (bf16*)(ws + WS_XB); bf16* QKV = (bf16*)(ws + WS_QKV); bf16* Y = (bf16*)(ws + WS_Y); float* KMEAN = (float*)(ws + WS_KMEAN); bf16* KFb = (bf16*)(ws + WS_KF); bf16* VFb = (bf16*)(ws + WS_VF);
    float* OUT = a.out;
    const int lo = a.ph_lo, hi = a.ph_hi;
    unsigned* barw = (unsigned*)(ws + 65536);
    volatile LAS unsigned* bst = (volatile LAS unsigned*)(lds + 131072);
    if (threadIdx.x < 4) bst[threadIdx.x] = 0u;
    __syncthreads();
    if (N_LAUNCH == 1 && threadIdx.x == 0) (void)xb_add(&barw[XB_XCNT(xb_xcc_id())], 1u);
    if (hi > 1000) cg::this_grid().sync();
#define IN(k) (lo <= (k) && (k) < hi)
#define SEAM(k) do { if ((k) + 1 < hi) { if (N_LAUNCH != 1) cg::this_grid().sync(); \
                                         else { XcdBarrier xb_; xb_.bar = barw; xb_.x = xb_xcc_id(); xb_.st = bst; xcd_barrier(xb_); } } } while (0)

#ifndef S3M
#define S3M 0xff
#endif
#ifndef ONLY
#define ONLY 0xff
#endif
    if ((ONLY & 1) && IN(0)) {
        int t0_ = threadIdx.x; asm volatile("" : "+v"(t0_)); const int lane = t0_ & 63, wave = __builtin_amdgcn_readfirstlane(t0_ >> 6);
        LAS float* scr = (LAS float*)(lds + wave * 16384);
        const int gw = bx * NWAVES + wave, NGW = G * NWAVES;
        constexpr int I_IN = 16 * (PW / 32), I_BR = 8 * 32, I_OUT = 16 * 32, I_G = 16 * (FF / 32), I_DN = (FF / 64) * 32;
        constexpr int I_L = I_IN + 3 * I_BR + I_OUT + 2 * I_G + I_DN;
        for (int it = gw; it < NLAYER * I_L; it += NGW) {
            const int L = it / I_L; int r = it - L * I_L;
            bf16* wb = (bf16*)(ws + WS_W + (size_t)L * LW_SIZE);
            if (r < I_IN) { transpose_item(a.in[1] + (size_t)L * DM * PW, DM, PW, wb + LW_IN / 2, 0, scr, r, lane); continue; } r -= I_IN;
            if (r < 3 * I_BR) { const int br = r / I_BR; transpose_item(a.in[4 + br] + (size_t)L * 512 * DM, 512, DM, wb + LW_BR / 2 + (size_t)br * 1024 * 512, 0, scr, r - br * I_BR, lane); continue; } r -= 3 * I_BR;
            if (r < I_OUT) { transpose_item(a.in[7] + (size_t)L * DM * DM, DM, DM, wb + LW_OUT / 2, 0, scr, r, lane); continue; } r -= I_OUT;
            if (r < I_G) { transpose_item(a.in[10] + (size_t)L * DM * FF, DM, FF, wb + LW_GU / 2, 1, scr, r, lane); continue; } r -= I_G;
            if (r < I_G) { transpose_item(a.in[11] + (size_t)L * DM * FF, DM, FF, wb + LW_GU / 2, 2, scr, r, lane); continue; } r -= I_G;
            transpose_item(a.in[12] + (size_t)L * FF * DM, FF, DM, wb + LW_DN / 2, 0, scr, r, lane);
        }
        for (int pm = bx; pm < NPANEL; pm += G) cvt_panel(pm, a.in[0], XB);
        asm volatile("s_waitcnt vmcnt(0) lgkmcnt(0)" ::: "memory"); WG_BAR();
        SEAM(0);
    }

    for (int L = 0; L < NLAYER; ++L) {
        const bf16* wb = (const bf16*)(ws + WS_W + (size_t)L * LW_SIZE);
        const bf16* W_IN = wb + LW_IN / 2; const bf16* W_BR = wb + LW_BR / 2; const bf16* W_OUT = wb + LW_OUT / 2; const bf16* W_GU = wb + LW_GU / 2; const bf16* W_DN = wb + LW_DN / 2;
        const int P1 = 1 + 3 * L, P2 = 2 + 3 * L, P3 = 3 + 3 * L;
        if ((ONLY & 2) && IN(P1)) {
            for (int pm = bx; pm < NPANEL; pm += G) {
                pg8::Gemm g{XB, W_IN, DM, DM, (size_t)256 * DM * 2}; pg8::PanelSched S{pm, PA / 256};
                LAS float* KS = (LAS float*)(lds + 131072 + 64);
                { int t_ = threadIdx.x; asm volatile("" : "+v"(t_)); KS[t_] = 0.f; }
                WG_BAR();
                pg8::EpiStoreS1 E{QKV, PA, QKV_PSTR, KFb, KS};
                pg8::gemm_phase<pg8::EpiStoreS1, pg8::PanelSched, true, true>(lds, g, S, E);
                asm volatile("s_waitcnt vmcnt(0) lgkmcnt(0)" ::: "memory"); WG_BAR();
                { int t_ = threadIdx.x; asm volatile("" : "+v"(t_));
                  KMEAN[((size_t)((pm >> 5) * 8 + (t_ >> 6)) * 32 + (pm & 31)) * 64 + (t_ & 63)] = KS[t_] * (1.f / 256.f); }
                kvfrag_panel(pm, QKV, KFb, VFb, lds);
                WG_BAR();
            }
            SEAM(P1);
        }
        if ((ONLY & 4) && IN(P2)) {
            if (G == 256) {
                for (int i = 0; i < 8; ++i) { const int bh = (vcu >> 5) * 8 + i, base = ((vcu & 31) + 8 * (i >> 1)) & 31, qb = (i & 1) ? 31 - base : base;
                    moba_unit(bh >> 3, bh & 7, qb, QKV, KFb, VFb, Y, KMEAN, lds); }
            } else {
                for (int u = vcu; u < 2048; u += G) moba_unit(u >> 8, (u >> 5) & 7, u & 31, QKV, KFb, VFb, Y, KMEAN, lds);
            }
            swa_phase(vcu, G, QKV, Y, a.in[2] + L * 8, lds);
            for (int u = bx; u < 1024; u += G) conv_unit(u, QKV, Y, a.in[3] + (size_t)L * 3 * 512);
            SEAM(P2);
        }
        if ((ONLY & 8) && IN(P3)) {
            for (int pm = bx; pm < NPANEL; pm += G) {
                bf16* Gb = QKV + OV_G; bf16* Mg = QKV + OV_MG; bf16* Hb = QKV + OV_H;
                for (int br = 0; br < 3; ++br) {
                    if (S3M & 1) { pg8::Gemm g{XB, W_IN + (size_t)(PA + br * 1024) * DM, DM, DM, (size_t)256 * DM * 2}; pg8::PanelSched S{pm, 4};
                      pg8::EpiStore<1> E{Gb, 1024, QKV_PSTR};
                      pg8::gemm_phase<pg8::EpiStore<1>, pg8::PanelSched, true, true>(lds, g, S, E); }
                    asm volatile("s_waitcnt vmcnt(0)" ::: "memory"); WG_BAR();
                    if (S3M & 2) { pg8::Gemm g{Y + br * 512, W_BR + (size_t)br * 1024 * 512, 512, 1536, (size_t)256 * 1536 * 2}; pg8::PanelSched S{pm, 4};
                      pg8::EpiBranch E{Gb, Mg, QKV_PSTR, br == 0 ? 1 : 0};
                      pg8::gemm_phase<pg8::EpiBranch, pg8::PanelSched, true, true>(lds, g, S, E); }
                    asm volatile("s_waitcnt vmcnt(0)" ::: "memory"); WG_BAR();
                }
                if (S3M & 4) { pg8::Gemm g{Mg, W_OUT, DM, DM, QKV_PSTR * 2}; pg8::PanelSched S{pm, 4};
                  pg8::EpiStore<0> E{QKV + OV_D1, 1024, QKV_PSTR};
                  pg8::gemm_phase<pg8::EpiStore<0>, pg8::PanelSched, true, true>(lds, g, S, E); }
                asm volatile("s_waitcnt vmcnt(0)" ::: "memory"); WG_BAR();
                bf16* LOY = Y + (size_t)pm * 256 * 1536; bf16* LOX = (bf16*)(OUT + (size_t)pm * 256 * DM);
                ln_panel(pm, L == 0 ? a.in[0] : (const float*)nullptr, LOX, QKV + OV_D1 + (size_t)pm * QKV_PSTR, OUT, a.in[8] + L * DM, a.in[9] + L * DM, XB, LOY, false, ALPHA_DN);
                asm volatile("s_waitcnt vmcnt(0)" ::: "memory"); WG_BAR();
                if (S3M & 16) { pg8::Gemm g{XB, W_GU, DM, DM, (size_t)256 * DM * 2}; pg8::PanelSched S{pm, 2 * FF / 256};
                  pg8::EpiSwiglu E{Hb, QKV_PSTR};
                  pg8::gemm_phase<pg8::EpiSwiglu, pg8::PanelSched, true, true>(lds, g, S, E); }
                asm volatile("s_waitcnt vmcnt(0)" ::: "memory"); WG_BAR();
                if (S3M & 32) { pg8::Gemm g{Hb, W_DN, FF, FF, QKV_PSTR * 2}; pg8::PanelSched S{pm, 4};
                  pg8::EpiStore<0> E{QKV + OV_D2, 1024, QKV_PSTR};
                  pg8::gemm_phase<pg8::EpiStore<0>, pg8::PanelSched, true, true>(lds, g, S, E); }
                asm volatile("s_waitcnt vmcnt(0)" ::: "memory"); WG_BAR();
                ln_panel(pm, (const float*)nullptr, LOY, QKV + OV_D2 + (size_t)pm * QKV_PSTR, OUT, a.in[13] + L * DM, a.in[14] + L * DM, XB, LOX, L == NLAYER - 1, ALPHA_DN);
                asm volatile("s_waitcnt vmcnt(0)" ::: "memory"); WG_BAR();
            }
        }
    }
#undef IN
#undef SEAM
}

extern "C" void kernel_launch(void* const* d_in, const int* in_sizes, int n_in, void* d_out, int out_size, void* d_ws, size_t ws_size, hipStream_t stream) {
    static int grid = 0;
    if (grid == 0) {
        if (n_in != 15 || in_sizes[0] != MTOK * DM || out_size != MTOK * DM || ws_size < WS_END) {
            fprintf(stderr, "kernel_launch: unexpected shapes (n_in %d in0 %d out %d ws %zu need %zu)\n", n_in, n_in > 0 ? in_sizes[0] : -1, out_size, ws_size, (size_t)WS_END); grid = -1; return; }
        int dev = 0, cus = 0, per_cu = 0;
        hipGetDevice(&dev); hipDeviceGetAttribute(&cus, hipDeviceAttributeMultiprocessorCount, dev);
        hipFuncSetAttribute((const void*)fwd_kernel, hipFuncAttributeMaxDynamicSharedMemorySize, LDS_BYTES);
        hipOccupancyMaxActiveBlocksPerMultiprocessor(&per_cu, (const void*)fwd_kernel, NTHR, LDS_BYTES);
        (void)hipGetLastError();
        if (per_cu < 1) per_cu = 1;
        grid = cus * per_cu; if (grid > NPANEL) grid = NPANEL; if (grid < 1) grid = 1;
    }
    if (grid < 0) return;
    if (N_LAUNCH == 1) (void)hipMemsetAsync((char*)d_ws + 65536, 0, (size_t)XCD_BAR_WORDS * 4, stream);
    Args a{};
    for (int i = 0; i < 15; ++i) a.in[i] = (const float*)d_in[i];
    a.out = (float*)d_out; a.ws = (unsigned char*)d_ws;
#if N_LAUNCH == 1
    a.ph_lo = 0; a.ph_hi = 7;
    void* args[] = {&a};
    hipError_t e = hipLaunchCooperativeKernel((const void*)fwd_kernel, dim3(grid), dim3(NTHR), args, LDS_BYTES, stream);
    if (e != hipSuccess) fprintf(stderr, "cooperative launch failed: %s (grid %d)\n", hipGetErrorString(e), grid);
#else
    const int cuts[7] = {0, 1, 2, 3, 5, 6, 7};
    for (int li = 0; li < 6; ++li) { a.ph_lo = cuts[li]; a.ph_hi = cuts[li + 1]; hipLaunchKernelGGL(fwd_kernel, dim3(grid), dim3(NTHR), LDS_BYTES, stream, a); }
#endif
}
```
